# Optimizing an MI355X kernel written in HIP

```python
import jax, jax.numpy as jnp
from jax import lax
import numpy as np

D_MODEL = 1024
BATCH = 1
SEQ = 16384
DEPTH = 1

N_HEADS = 16
HEAD_DIM = 64
N_KV_GROUPS = 2
HEADS_PER_GROUP = N_HEADS // N_KV_GROUPS
CMP_BLOCK = 32
CMP_STRIDE = 16
CMP_HIDDEN = 256
SLC_BLOCK = 64
N_SELECT = 16
WINDOW = 512
Q_BLOCK = 128
CONV_WIDTH = 1024
CONV_K = 3
D_FF = 2816
EPS = 1e-6
NEG_INF = -1e30
FORCE_SCORE = 1e9

Q_COLS = N_HEADS * HEAD_DIM
KV_COLS = N_KV_GROUPS * HEAD_DIM
IN_WIDTHS = (Q_COLS, KV_COLS, KV_COLS, KV_COLS, KV_COLS, KV_COLS, KV_COLS, N_HEADS * 3,
             CONV_WIDTH, CONV_WIDTH, CONV_WIDTH, D_MODEL, D_MODEL)
IN_TOTAL = sum(IN_WIDTHS)

kernel_name = "hybrid_nsa_shortconv_macaron"


def rms_norm(x, g):
    xf = x.astype(jnp.float32)
    y = xf * lax.rsqrt(jnp.mean(xf * xf, axis=-1, keepdims=True) + EPS)
    return (y * g.astype(jnp.float32)).astype(x.dtype)


def swiglu(x, w_gate, w_up, w_down):
    return (jax.nn.silu(x @ w_gate) * (x @ w_up)) @ w_down


def compress_blocks(kv, pe, w1, w2):
    b, s, g, d = kv.shape
    chunks = kv.reshape(b, s // CMP_STRIDE, CMP_STRIDE, g, d)
    blocks = jnp.concatenate([chunks[:, :-1], chunks[:, 1:]], axis=2)
    blocks = blocks + pe[None, None, :, None, :]
    n_cmp = blocks.shape[1]
    flat = blocks.transpose(0, 1, 3, 2, 4).reshape(b, n_cmp, g, CMP_BLOCK * d)
    return jax.nn.gelu(flat @ w1) @ w2


def nsa_attention(q, kc, vc, k_slc, v_slc, k_win, v_win):
    b, s, h, d = q.shape
    g = N_KV_GROUPS
    scale = d ** -0.5
    n_cmp = kc.shape[1]
    n_slc = s // SLC_BLOCK
    n_sel = min(N_SELECT, n_slc)
    cmp_start = jnp.arange(n_cmp) * CMP_STRIDE
    cmp_end = cmp_start + CMP_BLOCK - 1
    slc_start = jnp.arange(n_slc) * SLC_BLOCK
    overlap = ((cmp_start[:, None] < slc_start[None, :] + SLC_BLOCK)
               & (cmp_start[:, None] + CMP_BLOCK > slc_start[None, :])).astype(jnp.float32)
    ks_blocks = k_slc.reshape(b, n_slc, SLC_BLOCK, g, d).transpose(0, 3, 1, 2, 4)
    vs_blocks = v_slc.reshape(b, n_slc, SLC_BLOCK, g, d).transpose(0, 3, 1, 2, 4)
    kw = jnp.pad(k_win, ((0, 0), (WINDOW, 0), (0, 0), (0, 0)))
    vw = jnp.pad(v_win, ((0, 0), (WINDOW, 0), (0, 0), (0, 0)))
    qg = q.reshape(b, s, g, HEADS_PER_GROUP, d)
    b_idx = jnp.arange(b)[:, None, None, None]
    g_idx = jnp.arange(g)[None, :, None, None]
    blk = jnp.arange(n_slc)

    def query_block(i):
        q0 = i * Q_BLOCK
        qb = lax.dynamic_slice_in_dim(qg, q0, Q_BLOCK, axis=1)
        t = q0 + jnp.arange(Q_BLOCK)
        sc = jnp.einsum('bqghd,bcgd->bghqc', qb, kc).astype(jnp.float32) * scale
        valid_c = cmp_end[None, :] <= t[:, None]
        pc = jax.nn.softmax(jnp.where(valid_c, sc, NEG_INF), axis=-1)
        pc = jnp.where(valid_c, pc, 0.0)
        o_cmp = jnp.einsum('bghqc,bcgd->bqghd', pc.astype(vc.dtype), vc)
        ps = jnp.einsum('bghqc,cn->bgqn', pc, overlap)
        cur = t // SLC_BLOCK
        forced = (blk[None, :] == 0) | (blk[None, :] == cur[:, None]) | (blk[None, :] == cur[:, None] - 1)
        causal_blk = blk[None, :] * SLC_BLOCK <= t[:, None]
        ps = jnp.where(forced, FORCE_SCORE, jnp.where(causal_blk, ps, -1.0))
        _, idx = lax.top_k(ps, n_sel)
        ksel = ks_blocks[b_idx, g_idx, idx].reshape(b, g, Q_BLOCK, n_sel * SLC_BLOCK, d)
        vsel = vs_blocks[b_idx, g_idx, idx].reshape(b, g, Q_BLOCK, n_sel * SLC_BLOCK, d)
        pos = (idx[..., None] * SLC_BLOCK + jnp.arange(SLC_BLOCK)).reshape(b, g, Q_BLOCK, n_sel * SLC_BLOCK)
        valid_s = (pos <= t[:, None])[:, :, None]
        ss = jnp.einsum('bqghd,bgqkd->bghqk', qb, ksel).astype(jnp.float32) * scale
        psel = jax.nn.softmax(jnp.where(valid_s, ss, NEG_INF), axis=-1)
        o_slc = jnp.einsum('bghqk,bgqkd->bqghd', psel.astype(vsel.dtype), vsel)
        kwb = lax.dynamic_slice_in_dim(kw, q0, WINDOW + Q_BLOCK, axis=1)
        vwb = lax.dynamic_slice_in_dim(vw, q0, WINDOW + Q_BLOCK, axis=1)
        wpos = q0 - WINDOW + jnp.arange(WINDOW + Q_BLOCK)
        diff = t[:, None] - wpos[None, :]
        valid_w = (diff >= 0) & (diff < WINDOW) & (wpos[None, :] >= 0)
        sw = jnp.einsum('bqghd,bkgd->bghqk', qb, kwb).astype(jnp.float32) * scale
        pw = jax.nn.softmax(jnp.where(valid_w, sw, NEG_INF), axis=-1)
        o_win = jnp.einsum('bghqk,bkgd->bqghd', pw.astype(vwb.dtype), vwb)
        return o_cmp, o_slc, o_win

    o_cmp, o_slc, o_win = lax.map(query_block, jnp.arange(s // Q_BLOCK))

    def unblock(o):
        return o.transpose(1, 0, 2, 3, 4, 5).reshape(b, s, h, d)

    return unblock(o_cmp), unblock(o_slc), unblock(o_win)


def short_gated_conv(b_gate, c_gate, x_in, conv_w):
    u = c_gate * x_in
    conv = lax.conv_general_dilated(u, conv_w[:, None, :], window_strides=(1,),
                                    padding=[(CONV_K - 1, 0)],
                                    dimension_numbers=('NWC', 'WIO', 'NWC'),
                                    feature_group_count=CONV_WIDTH)
    return b_gate * conv


def setup_inputs(seed: int = 0) -> dict:
    key = jax.random.key(seed)
    ks = jax.random.split(key, 24)
    L = DEPTH

    def w(k, shape, fan_in):
        return jax.random.normal(k, shape, jnp.float32) * fan_in ** -0.5

    def gain(k):
        return 1.0 + 0.01 * jax.random.normal(k, (L, D_MODEL), jnp.float32)

    flat_cmp = CMP_BLOCK * HEAD_DIM
    return {
        "x": jax.random.normal(ks[0], (BATCH, SEQ, D_MODEL), jnp.float32),
        "ffn1_norm": gain(ks[1]),
        "ffn1_w_gate": w(ks[2], (L, D_MODEL, D_FF), D_MODEL),
        "ffn1_w_up": w(ks[3], (L, D_MODEL, D_FF), D_MODEL),
        "ffn1_w_down": w(ks[4], (L, D_FF, D_MODEL), D_FF),
        "mix_norm": gain(ks[5]),
        "w_in": w(ks[6], (L, D_MODEL, IN_TOTAL), D_MODEL),
        "cmp_pe_k": 0.02 * jax.random.normal(ks[7], (L, CMP_BLOCK, HEAD_DIM), jnp.float32),
        "cmp_pe_v": 0.02 * jax.random.normal(ks[8], (L, CMP_BLOCK, HEAD_DIM), jnp.float32),
        "cmp_k_w1": w(ks[9], (L, flat_cmp, CMP_HIDDEN), flat_cmp),
        "cmp_k_w2": w(ks[10], (L, CMP_HIDDEN, HEAD_DIM), CMP_HIDDEN),
        "cmp_v_w1": w(ks[11], (L, flat_cmp, CMP_HIDDEN), flat_cmp),
        "cmp_v_w2": w(ks[12], (L, CMP_HIDDEN, HEAD_DIM), CMP_HIDDEN),
        "conv_w": w(ks[13], (L, CONV_K, CONV_WIDTH), CONV_K),
        "w_nsa_out": w(ks[14], (L, N_HEADS * HEAD_DIM, D_MODEL), N_HEADS * HEAD_DIM),
        "w_conv_out": w(ks[15], (L, CONV_WIDTH, D_MODEL), CONV_WIDTH),
        "w_out": w(ks[16], (L, D_MODEL, D_MODEL), D_MODEL),
        "ffn2_norm": gain(ks[17]),
        "ffn2_w_gate": w(ks[18], (L, D_MODEL, D_FF), D_MODEL),
        "ffn2_w_up": w(ks[19], (L, D_MODEL, D_FF), D_MODEL),
        "ffn2_w_down": w(ks[20], (L, D_FF, D_MODEL), D_FF),
        "final_norm": 1.0 + 0.01 * jax.random.normal(ks[21], (D_MODEL,), jnp.float32),
    }


def reference(x, ffn1_norm, ffn1_w_gate, ffn1_w_up, ffn1_w_down, mix_norm, w_in,
              cmp_pe_k, cmp_pe_v, cmp_k_w1, cmp_k_w2, cmp_v_w1, cmp_v_w2, conv_w,
              w_nsa_out, w_conv_out, w_out, ffn2_norm, ffn2_w_gate, ffn2_w_up,
              ffn2_w_down, final_norm):
    b, s, _ = x.shape
    split_at = [int(v) for v in np.cumsum(IN_WIDTHS)[:-1]]
    for l in range(DEPTH):
        x = x + 0.5 * swiglu(rms_norm(x, ffn1_norm[l]), ffn1_w_gate[l], ffn1_w_up[l], ffn1_w_down[l])
        h = rms_norm(x, mix_norm[l])
        proj = h @ w_in[l]
        (q, k_c, v_c, k_s, v_s, k_w, v_w, nsa_g,
         conv_b, conv_c, conv_x, gate_a, gate_b) = jnp.split(proj, split_at, axis=-1)
        q = q.reshape(b, s, N_HEADS, HEAD_DIM)
        kv_shape = (b, s, N_KV_GROUPS, HEAD_DIM)
        kc = compress_blocks(k_c.reshape(kv_shape), cmp_pe_k[l], cmp_k_w1[l], cmp_k_w2[l])
        vc = compress_blocks(v_c.reshape(kv_shape), cmp_pe_v[l], cmp_v_w1[l], cmp_v_w2[l])
        o_cmp, o_slc, o_win = nsa_attention(q, kc, vc, k_s.reshape(kv_shape), v_s.reshape(kv_shape),
                                            k_w.reshape(kv_shape), v_w.reshape(kv_shape))
        g3 = jax.nn.sigmoid(nsa_g.reshape(b, s, N_HEADS, 3))
        o_nsa = g3[..., 0:1] * o_cmp + g3[..., 1:2] * o_slc + g3[..., 2:3] * o_win
        y_a = o_nsa.reshape(b, s, N_HEADS * HEAD_DIM) @ w_nsa_out[l]
        y_b = short_gated_conv(conv_b, conv_c, conv_x, conv_w[l]) @ w_conv_out[l]
        merged = jax.nn.sigmoid(gate_a) * y_a + jax.nn.sigmoid(gate_b) * y_b
        x = x + merged @ w_out[l]
        x = x + 0.5 * swiglu(rms_norm(x, ffn2_norm[l]), ffn2_w_gate[l], ffn2_w_up[l], ffn2_w_down[l])
    return rms_norm(x, final_norm)
```

```cpp
#include <hip/hip_runtime.h>
#include <hip/hip_cooperative_groups.h>
#include <cstdio>
#include <cstdint>
namespace cg = cooperative_groups;

#ifndef MK_PER_PHASE
#define MK_PER_PHASE 0
#endif

#define LAS __attribute__((address_space(3)))
typedef unsigned short bf16_t;
typedef short bf16x8 __attribute__((ext_vector_type(8)));
typedef short bf16x4 __attribute__((ext_vector_type(4)));
typedef float f32x4 __attribute__((ext_vector_type(4)));
typedef unsigned u32x4 __attribute__((ext_vector_type(4)));
typedef unsigned u32x2 __attribute__((ext_vector_type(2)));

constexpr int M = 16384, D = 1024, FF = 2816, NP = 7168, IN_TOTAL = 6960;
constexpr int NWAVES = 8, NTHREADS = 512;
constexpr float EPS = 1e-6f;
constexpr float LOG2E = 1.4426950408889634f;
constexpr float SC = 0.125f * LOG2E;
constexpr int LDS_BYTES = 157696;

constexpr size_t MiB = 1u << 20;
constexpr size_t WS_SSQ = 0;
constexpr size_t WS_KC = 1 * MiB;
constexpr size_t WS_VCT = 1 * MiB + 256 * 1024;
constexpr size_t WS_WK2 = 1 * MiB + 512 * 1024;
constexpr size_t WS_WV2 = 1 * MiB + 544 * 1024;
constexpr size_t WS_WK1 = 2 * MiB;
constexpr size_t WS_WV1 = 3 * MiB;
constexpr size_t WS_W1A = 4 * MiB;
constexpr size_t WS_W1D = 15 * MiB;
constexpr size_t WS_KB = 4 * MiB;
constexpr size_t WS_WIN = 21 * MiB;
constexpr size_t WS_XB = 35 * MiB;
constexpr size_t WS_WNA = 35 * MiB, WS_WCO = 37 * MiB, WS_WO = 39 * MiB, WS_W2A = 41 * MiB, WS_W2D = 52 * MiB;
constexpr size_t WS_QO = 67 * MiB;
constexpr size_t WS_VT = 99 * MiB;
constexpr size_t WS_G = 107 * MiB;
constexpr size_t WS_CB = 111 * MiB, WS_CU = 143 * MiB, WS_GA = 175 * MiB, WS_GB = 207 * MiB;
constexpr size_t WS_HB = 111 * MiB;
constexpr size_t WS_CTL = 20 * MiB + 512 * 1024;
constexpr size_t WS_RS0 = WS_CTL + 8192, WS_RSA = WS_RS0 + 65536, WS_RSB = WS_RSA + 65536;
constexpr size_t WS_RSC = WS_RSB + 65536;
constexpr size_t WS_PCNT = WS_CTL + 4096;
constexpr size_t CTL_BYTES = 8192 + 4 * 65536;
static_assert(WS_CTL + CTL_BYTES <= WS_WIN && WS_CTL >= WS_W1D + (size_t)1024 * 2816 * 2, "control region sits in the free gap between W1D and WIN");
constexpr size_t WS_END = 239 * MiB;

typedef float f32x2_t __attribute__((ext_vector_type(2)));
typedef __bf16 bf16x2_t __attribute__((ext_vector_type(2)));
__device__ __forceinline__ unsigned cvt_pk_bf16(float lo, float hi) { f32x2_t v = {lo, hi}; bf16x2_t b = __builtin_convertvector(v, bf16x2_t); return __builtin_bit_cast(unsigned, b); }
__device__ __forceinline__ float bf2f(unsigned short b) { return __builtin_bit_cast(float, (unsigned)b << 16); }
__device__ __forceinline__ float bflo(unsigned w) { return __builtin_bit_cast(float, w << 16); }
__device__ __forceinline__ float bfhi(unsigned w) { return __builtin_bit_cast(float, w & 0xffff0000u); }
__device__ __forceinline__ float fexp2(float x) { return __builtin_amdgcn_exp2f(x); }
__device__ __forceinline__ float frcp(float x) { return __builtin_amdgcn_rcpf(x); }
__device__ __forceinline__ float sigmoidf_(float x) { return frcp(1.f + fexp2(-x * LOG2E)); }
__device__ __forceinline__ float wave_sum(float v) {
#pragma unroll
    for (int o = 1; o < 64; o <<= 1) v += __shfl_xor(v, o);
    return v;
}
__device__ __forceinline__ float rs_row(const float* ssq, int row) {
    const float* p = ssq + (size_t)row * 16;
    f32x4 a, b, c, d;
    asm volatile("global_load_dwordx4 %0, %4, off sc1\n\tglobal_load_dwordx4 %1, %4, off offset:16 sc1\n\tglobal_load_dwordx4 %2, %4, off offset:32 sc1\n\tglobal_load_dwordx4 %3, %4, off offset:48 sc1\n\ts_waitcnt vmcnt(0)"
                 : "=&v"(a), "=&v"(b), "=&v"(c), "=&v"(d) : "v"(p) : "memory");
    float s = ((a.x + a.y) + (a.z + a.w)) + ((b.x + b.y) + (b.z + b.w)) + ((c.x + c.y) + (c.z + c.w)) + ((d.x + d.y) + (d.z + d.w));
    return rsqrtf(s * (1.f / 1024.f) + EPS);
}

namespace pg8 {
constexpr int BM = 256, BK = 64, HALF = 128, HTB = HALF * BK * 2, NXCD = 8, WGM = 8;
__host__ __device__ __forceinline__ int lds_byte(int r, int c) { const int st = (r >> 4) * 2 + (c >> 5), rr = r & 15, cc = c & 31, ob = rr * 64 + cc * 2; return st * 1024 + (ob ^ (((ob >> 9) & 1) << 5)); }
__host__ __device__ __forceinline__ void stage_rc(int b, int& R, int& C) { const int st = b / 1024, sb = b % 1024, swz = sb ^ (((sb >> 9) & 1) << 5); R = (st >> 1) * 16 + swz / 64; C = (st & 1) * 32 + (swz % 64) / 2; }
__host__ __device__ __forceinline__ int perm32(int rho) { const int n = rho >> 4, i = rho & 15; return 8 * (i >> 2) + 4 * n + (i & 3); }
struct Unit { int pm, pn; };
struct Gemm { const bf16_t* A; const bf16_t* Bt; int M, N, K; };
struct StaticOrder {
    int nM, nN, nwg, G, c;
    __host__ __device__ void init(int M_, int N_, int G_, int c_) { nM = M_ / BM; nN = N_ / BM; nwg = nM * nN; G = G_; c = c_; }
    __host__ __device__ bool next(int i, Unit& u) const {
        const long L = (long)i * G + c; if (L >= nwg) return false;
        int wgid = (int)L; { const int q = nwg / NXCD, r = nwg % NXCD, xcd = wgid % NXCD, off = wgid / NXCD; wgid = (xcd < r ? xcd * (q + 1) : r * (q + 1) + (xcd - r) * q) + off; }
        const int nig = WGM * nN, gid = wgid / nig, fm = gid * WGM, gsz = (nM - fm) < WGM ? (nM - fm) : WGM;
        u.pm = fm + ((wgid % nig) % gsz); u.pn = (wgid % nig) / gsz; return true;
    }
};
template <class Epi>
__device__ __forceinline__ void gemm_phase(LAS unsigned char* lds, const Gemm g, const StaticOrder& S, const Epi& E) {
    const int tid = threadIdx.x, wid = __builtin_amdgcn_readfirstlane(tid >> 6), lane = tid & 63, wr = wid >> 2, wc = wid & 3, fr = lane & 15, fq = lane >> 4;
    const int K = g.K, nt = K / BK;
    unsigned voffA[2], voffB[2];
#pragma unroll
    for (int i = 0; i < 2; ++i) { int R, C; stage_rc(tid * 16 + i * 8192, R, C); const int Rb = (R & ~31) + perm32(R & 31);
        voffA[i] = (unsigned)(R * K + C) * 2u; voffB[i] = (unsigned)(Rb * K + C) * 2u; }
    const size_t kstep = (size_t)(BK * 2);
    const size_t hstep = (size_t)HALF * K * 2;
    const size_t tstep = 2 * hstep;
    const unsigned ldsw = (unsigned)wid * 1024u;
    const int aoff = lds_byte(wr * 64 + fr, fq * 8), boff = lds_byte(wc * 32 + fr, fq * 8);
#define PG8_SA(b, h) (((b) * 2 + (h)) * HTB)
#define PG8_SB(b, h) ((4 + (b) * 2 + (h)) * HTB)
#define PG8_STAGE(bufoff, gbase, voff) do { _Pragma("unroll") for (int _i = 0; _i < 2; ++_i) \
        __builtin_amdgcn_global_load_lds((const unsigned*)((const char*)(gbase) + (voff)[_i]), (LAS unsigned*)(lds + (bufoff) + ldsw + _i * 8192), 16, 0, 0); } while (0)
#define PG8_LDA(dst, b, h) do { _Pragma("unroll") for (int m = 0; m < 4; ++m) _Pragma("unroll") for (int k = 0; k < 2; ++k) dst[m][k] = *(const LAS bf16x8*)(lds + PG8_SA(b, h) + aoff + m * 2048 + k * 1024); } while (0)
#define PG8_LDB(dst, b, h) do { _Pragma("unroll") for (int n = 0; n < 2; ++n) _Pragma("unroll") for (int k = 0; k < 2; ++k) dst[n][k] = *(const LAS bf16x8*)(lds + PG8_SB(b, h) + boff + n * 2048 + k * 1024); } while (0)
#define PG8_MMA(ai, bj, At, Bt) do { __builtin_amdgcn_s_setprio(1); _Pragma("unroll") for (int m = 0; m < 4; ++m) _Pragma("unroll") for (int n = 0; n < 2; ++n) _Pragma("unroll") for (int k = 0; k < 2; ++k) \
        acc[ai][bj][m][n] = __builtin_amdgcn_mfma_f32_16x16x32_bf16(Bt[n][k], At[m][k], acc[ai][bj][m][n], 0, 0, 0); __builtin_amdgcn_s_setprio(0); } while (0)
#define PG8_WAIT_V(n) asm volatile("s_waitcnt vmcnt(" #n ")" ::: "memory")
#define PG8_WAIT_L(n) asm volatile("s_waitcnt lgkmcnt(" #n ")" ::: "memory")
#define PG8_BAR __builtin_amdgcn_s_barrier()
#define PG8_SCHED __builtin_amdgcn_sched_barrier(0)
    Unit cur, nxt; int ui = 0;
    if (!S.next(0, cur)) return;
    f32x4 acc[2][2][4][2];
#pragma unroll
    for (int a = 0; a < 2; ++a)
#pragma unroll
        for (int b = 0; b < 2; ++b)
#pragma unroll
            for (int m = 0; m < 4; ++m)
#pragma unroll
                for (int n = 0; n < 2; ++n) acc[a][b][m][n] = (f32x4){0.f, 0.f, 0.f, 0.f};
    bf16x8 At[4][2], B0[2][2], B1[2][2];
    const char* cA = (const char*)g.A + (size_t)cur.pm * tstep; const char* cB = (const char*)g.Bt + (size_t)cur.pn * tstep;
    PG8_STAGE(PG8_SB(0, 0), cB, voffB); PG8_STAGE(PG8_SB(0, 1), cB + hstep, voffB); PG8_STAGE(PG8_SA(0, 0), cA, voffA); PG8_STAGE(PG8_SA(0, 1), cA + hstep, voffA);
    if (wr == 1) PG8_BAR;
    PG8_WAIT_V(2); PG8_BAR;
    PG8_STAGE(PG8_SB(1, 0), cB + kstep, voffB); PG8_STAGE(PG8_SA(1, 0), cA + kstep, voffA); PG8_STAGE(PG8_SB(1, 1), cB + hstep + kstep, voffB);
    PG8_WAIT_V(6); PG8_BAR;
    for (;;) {
        const bool has_next = S.next(ui + 1, nxt);
        const char* nA = has_next ? (const char*)g.A + (size_t)nxt.pm * tstep : cA; const char* nB = has_next ? (const char*)g.Bt + (size_t)nxt.pn * tstep : cB;
        for (int t = 0; t < nt; t += 2) {
            const bool last = (t == nt - 2);
            const char* a1 = cA + (size_t)(t + 1) * kstep;
            const char* a2 = last ? nA : cA + (size_t)(t + 2) * kstep; const char* b2 = last ? nB : cB + (size_t)(t + 2) * kstep;
            const char* a3 = a2 + kstep; const char* b3 = b2 + kstep;
            PG8_LDB(B0, 0, 0); PG8_LDB(B1, 0, 1); PG8_SCHED; PG8_LDA(At, 0, 0); PG8_STAGE(PG8_SA(1, 1), a1 + hstep, voffA);
            PG8_WAIT_V(8); PG8_WAIT_L(0); PG8_BAR; PG8_MMA(0, 0, At, B0); PG8_MMA(0, 1, At, B1); PG8_BAR; PG8_SCHED;
            PG8_LDA(At, 0, 1); PG8_STAGE(PG8_SB(0, 0), b2, voffB); PG8_STAGE(PG8_SB(0, 1), b2 + hstep, voffB); PG8_STAGE(PG8_SA(0, 0), a2, voffA);
            PG8_WAIT_V(8); PG8_WAIT_L(0); PG8_BAR; PG8_MMA(1, 0, At, B0); PG8_MMA(1, 1, At, B1); PG8_BAR; PG8_SCHED;
            PG8_LDB(B0, 1, 0); PG8_LDB(B1, 1, 1); PG8_SCHED; PG8_LDA(At, 1, 0); PG8_STAGE(PG8_SA(0, 1), a2 + hstep, voffA);
            PG8_WAIT_V(8); PG8_WAIT_L(0); PG8_BAR; PG8_MMA(0, 0, At, B0); PG8_MMA(0, 1, At, B1); PG8_BAR; PG8_SCHED;
            PG8_LDA(At, 1, 1); PG8_STAGE(PG8_SB(1, 0), b3, voffB); PG8_STAGE(PG8_SB(1, 1), b3 + hstep, voffB); PG8_STAGE(PG8_SA(1, 0), a3, voffA);
            PG8_WAIT_V(8); PG8_WAIT_L(0); PG8_BAR; PG8_MMA(1, 0, At, B0); PG8_MMA(1, 1, At, B1); PG8_BAR; PG8_SCHED;
        }
        if (wr == 0) PG8_BAR;
        E(acc, cur, wr, wc, fr, fq);
        if (!has_next) break;
#pragma unroll
        for (int a = 0; a < 2; ++a)
#pragma unroll
            for (int b = 0; b < 2; ++b)
#pragma unroll
                for (int m = 0; m < 4; ++m)
#pragma unroll
                    for (int n = 0; n < 2; ++n) acc[a][b][m][n] = (f32x4){0.f, 0.f, 0.f, 0.f};
        cur = nxt; cA = nA; cB = nB; ++ui;
        if (wr == 1) PG8_BAR;
    }
    PG8_WAIT_V(0);
    PG8_BAR;
#undef PG8_SA
#undef PG8_SB
#undef PG8_STAGE
#undef PG8_LDA
#undef PG8_LDB
#undef PG8_MMA
#undef PG8_WAIT_V
#undef PG8_WAIT_L
#undef PG8_BAR
#undef PG8_SCHED
}

typedef f32x4 Acc[2][2][4][2];

struct EpiSwiglu {
    bf16_t* H; const float* rsum;
    __device__ __forceinline__ void operator()(const Acc& acc, const Unit& u, int wr, int wc, int fr, int fq) const {
        const int row0 = u.pm * BM + wr * 64 + fr, col0 = u.pn * 128 + wc * 32 + 8 * fq;
        float rsv[2][4];
#pragma unroll
        for (int ai = 0; ai < 2; ++ai)
#pragma unroll
            for (int m = 0; m < 4; ++m) rsv[ai][m] = rsum[row0 + ai * HALF + m * 16];
#pragma unroll
        for (int ai = 0; ai < 2; ++ai)
#pragma unroll
            for (int m = 0; m < 4; ++m) {
                const int row = row0 + ai * HALF + m * 16; const float rs = rsqrtf(rsv[ai][m] * (1.f / 1024.f) + EPS);
                float h[8];
#pragma unroll
                for (int n = 0; n < 2; ++n)
#pragma unroll
                    for (int i = 0; i < 4; ++i) { const float gt = acc[ai][0][m][n][i] * rs, up = acc[ai][1][m][n][i] * rs; h[n * 4 + i] = gt * sigmoidf_(gt) * up; }
                u32x4 w; w.x = cvt_pk_bf16(h[0], h[1]); w.y = cvt_pk_bf16(h[2], h[3]); w.z = cvt_pk_bf16(h[4], h[5]); w.w = cvt_pk_bf16(h[6], h[7]);
                *(u32x4*)(H + (size_t)row * FF + col0) = w;
            }
    }
};
struct EpiRes {
    const float* xin; float* xo; bf16_t* xb; float* rsum; float scale;
    __device__ __forceinline__ void operator()(const Acc& acc, const Unit& u, int wr, int wc, int fr, int fq) const {
        const int row0 = u.pm * BM + wr * 64 + fr, col0 = u.pn * BM + wc * 32 + 8 * fq;
#pragma unroll
        for (int ai = 0; ai < 2; ++ai)
#pragma unroll
            for (int m = 0; m < 4; ++m) {
                const int row = row0 + ai * HALF + m * 16; float ss = 0.f;
#pragma unroll
                for (int bj = 0; bj < 2; ++bj) {
                    const size_t off = (size_t)row * D + col0 + bj * HALF;
                    f32x4 x0 = __builtin_nontemporal_load((const f32x4*)(xin + off)), x1 = __builtin_nontemporal_load((const f32x4*)(xin + off + 4));
                    x0 = x0 + acc[ai][bj][m][0] * scale; x1 = x1 + acc[ai][bj][m][1] * scale;
                    __builtin_nontemporal_store(x0, (f32x4*)(xo + off)); __builtin_nontemporal_store(x1, (f32x4*)(xo + off + 4));
                    ss += (x0.x * x0.x + x0.y * x0.y) + (x0.z * x0.z + x0.w * x0.w) + (x1.x * x1.x + x1.y * x1.y) + (x1.z * x1.z + x1.w * x1.w);
                    if (xb) { u32x4 w; w.x = cvt_pk_bf16(x0.x, x0.y); w.y = cvt_pk_bf16(x0.z, x0.w); w.z = cvt_pk_bf16(x1.x, x1.y); w.w = cvt_pk_bf16(x1.z, x1.w); *(u32x4*)(xb + off) = w; }
                }
                ss += __shfl_xor(ss, 16); ss += __shfl_xor(ss, 32);
                if (fq == 0 && rsum) __hip_atomic_fetch_add(rsum + row, ss, __ATOMIC_RELAXED, __HIP_MEMORY_SCOPE_AGENT);
            }
    }
};
struct EpiFinal {
    float* xio; float* rsum; unsigned* pcnt; const float* gain;
    __device__ __forceinline__ void operator()(const Acc& acc, const Unit& u, int wr, int wc, int fr, int fq) const {
        const int row0 = u.pm * BM + wr * 64 + fr, col0 = u.pn * BM + wc * 32 + 8 * fq;
#pragma unroll
        for (int ai = 0; ai < 2; ++ai)
#pragma unroll
            for (int m = 0; m < 4; ++m) {
                const int row = row0 + ai * HALF + m * 16; float ss = 0.f;
#pragma unroll
                for (int bj = 0; bj < 2; ++bj) { const size_t off = (size_t)row * D + col0 + bj * HALF;
                    const f32x4 x0 = *(const f32x4*)(xio + off) + acc[ai][bj][m][0] * 0.5f, x1 = *(const f32x4*)(xio + off + 4) + acc[ai][bj][m][1] * 0.5f;
                    ss += (x0.x * x0.x + x0.y * x0.y) + (x0.z * x0.z + x0.w * x0.w) + (x1.x * x1.x + x1.y * x1.y) + (x1.z * x1.z + x1.w * x1.w); }
                ss += __shfl_xor(ss, 16); ss += __shfl_xor(ss, 32);
                if (fq == 0) __hip_atomic_fetch_add(rsum + row, ss, __ATOMIC_RELAXED, __HIP_MEMORY_SCOPE_AGENT);
            }
        asm volatile("s_waitcnt vmcnt(0) lgkmcnt(0)" ::: "memory");
        __syncthreads();
        if ((wr | wc | fr | fq) == 0) {
            unsigned* c = pcnt + 16 * u.pm;
            __hip_atomic_fetch_add(c, 1u, __ATOMIC_RELEASE, __HIP_MEMORY_SCOPE_AGENT);
            while (__hip_atomic_load(c, __ATOMIC_RELAXED, __HIP_MEMORY_SCOPE_AGENT) < 4u) __builtin_amdgcn_s_sleep(2);
        }
        __syncthreads();
#pragma unroll
        for (int ai = 0; ai < 2; ++ai)
#pragma unroll
            for (int m = 0; m < 4; ++m) {
                const int row = row0 + ai * HALF + m * 16;
                const float rs = rsqrtf(__hip_atomic_load(rsum + row, __ATOMIC_RELAXED, __HIP_MEMORY_SCOPE_AGENT) * (1.f / 1024.f) + EPS);
#pragma unroll
                for (int bj = 0; bj < 2; ++bj) { const size_t off = (size_t)row * D + col0 + bj * HALF;
                    const f32x4 g0 = *(const f32x4*)(gain + col0 + bj * HALF), g1 = *(const f32x4*)(gain + col0 + bj * HALF + 4);
                    const f32x4 x0 = (*(const f32x4*)(xio + off) + acc[ai][bj][m][0] * 0.5f) * rs * g0, x1 = (*(const f32x4*)(xio + off + 4) + acc[ai][bj][m][1] * 0.5f) * rs * g1;
                    __builtin_nontemporal_store(x0, (f32x4*)(xio + off)); __builtin_nontemporal_store(x1, (f32x4*)(xio + off + 4)); }
            }
    }
};
struct EpiWin {
    unsigned char* ws; const float* rsum;
    __device__ __forceinline__ void operator()(const Acc& acc, const Unit& u, int wr, int wc, int fr, int fq) const {
        const int row0 = u.pm * BM + wr * 64 + fr, cc0 = wc * 32 + 8 * fq;
        const int pn = u.pn;
        float rsv[2][4];
#pragma unroll
        for (int ai = 0; ai < 2; ++ai)
#pragma unroll
            for (int m = 0; m < 4; ++m) rsv[ai][m] = rsum[row0 + ai * HALF + m * 16];
#pragma unroll
        for (int ai = 0; ai < 2; ++ai)
#pragma unroll
            for (int m = 0; m < 4; ++m) {
                const int row = row0 + ai * HALF + m * 16; const float rs = rsqrtf(rsv[ai][m] * (1.f / 1024.f) + EPS);
                if (pn >= 12 && pn < 20) {
                    float v[8];
#pragma unroll
                    for (int n = 0; n < 2; ++n)
#pragma unroll
                        for (int i = 0; i < 4; ++i) v[n * 4 + i] = (acc[ai][0][m][n][i] * rs) * (acc[ai][1][m][n][i] * rs);
                    u32x4 w; w.x = cvt_pk_bf16(v[0], v[1]); w.y = cvt_pk_bf16(v[2], v[3]); w.z = cvt_pk_bf16(v[4], v[5]); w.w = cvt_pk_bf16(v[6], v[7]);
                    *(u32x4*)((bf16_t*)(ws + WS_CU) + (size_t)row * D + (pn - 12) * 128 + cc0) = w;
                    continue;
                }
#pragma unroll
                for (int bj = 0; bj < 2; ++bj) {
                    float v[8];
#pragma unroll
                    for (int n = 0; n < 2; ++n)
#pragma unroll
                        for (int i = 0; i < 4; ++i) v[n * 4 + i] = acc[ai][bj][m][n][i] * rs;
                    const int cc = bj * HALF + cc0;
                    if (pn == 7) {
                        if (cc < 48) { float* gp = (float*)(ws + WS_G) + (size_t)row * 48 + cc;
                            *(f32x4*)gp = (f32x4){sigmoidf_(v[0]), sigmoidf_(v[1]), sigmoidf_(v[2]), sigmoidf_(v[3])};
                            *(f32x4*)(gp + 4) = (f32x4){sigmoidf_(v[4]), sigmoidf_(v[5]), sigmoidf_(v[6]), sigmoidf_(v[7])}; }
                        continue;
                    }
                    if (pn == 6) {
                        bf16_t* vt = (bf16_t*)(ws + WS_VT) + ((size_t)(bj * 2 + (cc0 >> 6)) * 64 + (cc0 & 63)) * M + row;
#pragma unroll
                        for (int i = 0; i < 8; ++i) vt[(size_t)i * M] = (bf16_t)(cvt_pk_bf16(v[i], 0.f) & 0xffffu);
                        continue;
                    }
                    if (pn >= 20) {
#pragma unroll
                        for (int i = 0; i < 8; ++i) v[i] = sigmoidf_(v[i]);
                    }
                    u32x4 w; w.x = cvt_pk_bf16(v[0], v[1]); w.y = cvt_pk_bf16(v[2], v[3]); w.z = cvt_pk_bf16(v[4], v[5]); w.w = cvt_pk_bf16(v[6], v[7]);
                    bf16_t* dst;
                    if (pn < 4) dst = (bf16_t*)(ws + WS_QO) + (size_t)row * D + pn * BM + cc;
                    else if (pn < 6) dst = (bf16_t*)(ws + WS_KB) + (size_t)row * 512 + (pn - 4) * BM + cc;
                    else if (pn < 12) dst = (bf16_t*)(ws + WS_CB) + (size_t)row * D + (pn - 8) * BM + cc;
                    else if (pn < 24) dst = (bf16_t*)(ws + WS_GA) + (size_t)row * D + (pn - 20) * BM + cc;
                    else dst = (bf16_t*)(ws + WS_GB) + (size_t)row * D + (pn - 24) * BM + cc;
                    *(u32x4*)dst = w;
                }
            }
    }
};
template <int MODE> struct EpiMerge {
    bf16_t* T; const bf16_t* Sg;
    __device__ __forceinline__ void operator()(const Acc& acc, const Unit& u, int wr, int wc, int fr, int fq) const {
        const int row0 = u.pm * BM + wr * 64 + fr, col0 = u.pn * BM + wc * 32 + 8 * fq;
#pragma unroll
        for (int ai = 0; ai < 2; ++ai)
#pragma unroll
            for (int m = 0; m < 4; ++m) {
                const int row = row0 + ai * HALF + m * 16;
#pragma unroll
                for (int bj = 0; bj < 2; ++bj) {
                    const size_t off = (size_t)row * D + col0 + bj * HALF;
                    const u32x4 sg = *(const u32x4*)(Sg + off);
                    float v[8];
                    v[0] = bflo(sg.x) * acc[ai][bj][m][0][0]; v[1] = bfhi(sg.x) * acc[ai][bj][m][0][1]; v[2] = bflo(sg.y) * acc[ai][bj][m][0][2]; v[3] = bfhi(sg.y) * acc[ai][bj][m][0][3];
                    v[4] = bflo(sg.z) * acc[ai][bj][m][1][0]; v[5] = bfhi(sg.z) * acc[ai][bj][m][1][1]; v[6] = bflo(sg.w) * acc[ai][bj][m][1][2]; v[7] = bfhi(sg.w) * acc[ai][bj][m][1][3];
                    if (MODE == 1) { const u32x4 t = *(const u32x4*)(T + off);
                        v[0] += bflo(t.x); v[1] += bfhi(t.x); v[2] += bflo(t.y); v[3] += bfhi(t.y); v[4] += bflo(t.z); v[5] += bfhi(t.z); v[6] += bflo(t.w); v[7] += bfhi(t.w); }
                    u32x4 w; w.x = cvt_pk_bf16(v[0], v[1]); w.y = cvt_pk_bf16(v[2], v[3]); w.z = cvt_pk_bf16(v[4], v[5]); w.w = cvt_pk_bf16(v[6], v[7]);
                    *(u32x4*)(T + off) = w;
                }
            }
    }
};
}

__device__ __forceinline__ void tr_item(const float* W, int K, int N, int sc0, int nvalid, const float* gain, bf16_t* WT, int dr0, int k0, LAS float* scr, int lane) {
    const int nl = lane & 31;
    float tv[32];
#pragma unroll
    for (int i = 0; i < 32; ++i) { const int kk = 2 * i + (lane >> 5); tv[i] = (nl < nvalid) ? __builtin_nontemporal_load(W + (size_t)(k0 + kk) * N + sc0 + nl) : 0.f; }
    if (gain) {
#pragma unroll
        for (int i = 0; i < 32; ++i) tv[i] *= gain[k0 + 2 * i + (lane >> 5)];
    }
#pragma unroll
    for (int i = 0; i < 32; ++i) scr[(2 * i + (lane >> 5)) * 33 + nl] = tv[i];
    asm volatile("s_waitcnt lgkmcnt(0)" ::: "memory");
    const int c = lane & 7;
#pragma unroll
    for (int j = 0; j < 4; ++j) { const int n = (lane >> 3) + 8 * j; const LAS float* s = scr + (8 * c) * 33 + n;
        u32x4 o; o.x = cvt_pk_bf16(s[0 * 33], s[1 * 33]); o.y = cvt_pk_bf16(s[2 * 33], s[3 * 33]); o.z = cvt_pk_bf16(s[4 * 33], s[5 * 33]); o.w = cvt_pk_bf16(s[6 * 33], s[7 * 33]);
        *(u32x4*)(WT + (size_t)(dr0 + n) * K + k0 + 8 * c) = o; }
    asm volatile("s_waitcnt lgkmcnt(0)" ::: "memory");
}
__device__ __forceinline__ int win_src(int d0, int& nvalid) {
    nvalid = 32;
    if (d0 < 1152) return d0;
    if (d0 < 1280) return 1280 + (d0 - 1152);
    if (d0 < 1408) return 1536 + (d0 - 1280);
    if (d0 < 1536) return 1152 + (d0 - 1408);
    if (d0 < 1664) return 1408 + (d0 - 1536);
    if (d0 < 1792) return 1664 + (d0 - 1664);
    if (d0 < 2048) { const int o = d0 - 1792; nvalid = o < 48 ? (48 - o < 32 ? 48 - o : 32) : 0; return nvalid ? 1792 + o : 0; }
    if (d0 < 3072) return 1840 + (d0 - 2048);
    if (d0 < 5120) { const int o = d0 - 3072, tile = o >> 8, half = (o >> 7) & 1, i = o & 127; return (half ? 3888 : 2864) + tile * 128 + i; }
    if (d0 < 6144) return 4912 + (d0 - 5120);
    return 5936 + (d0 - 6144);
}

struct Args { const float* in[22]; float* out; unsigned char* ws; int ph_lo, ph_hi; };

__device__ __forceinline__ void conv_ffn_up_item(const float* wg, const float* wu, const float* gain, bf16_t* dst, int r, LAS float* scr, int lane) {
    const int kb = r / 176, nb = r % 176, d0 = nb * 32; const int tile = d0 >> 8, half = (d0 >> 7) & 1, i = d0 & 127;
    tr_item(half ? wu : wg, D, FF, tile * 128 + i, 32, gain, dst, d0, kb * 64, scr, lane);
}

__device__ __forceinline__ void compress_item(LAS unsigned char* lds, int item, const bf16_t* KB, const float* pe, const bf16_t* W1t, const bf16_t* W2t, bf16_t* KC, bf16_t* VCT, int kv) {
    const int tid = threadIdx.x, lane = tid & 63, w = __builtin_amdgcn_readfirstlane(tid >> 6), l15 = lane & 15, G = lane >> 4;
    const int rt = w >> 2, cgp = w & 3;
    constexpr int BS_OFF = 20480, BS_BYTES = 256 * 144, AS_OFF = BS_OFF + 2 * BS_BYTES, AS_BYTES = 32 * 144;
    f32x4 acc[4];
#pragma unroll
    for (int i = 0; i < 4; ++i) acc[i] = (f32x4){0.f, 0.f, 0.f, 0.f};
    const int ar = (tid >> 3) & 31, aseg = tid & 7;
    const int aR = item * 32 + ar; int ac = aR >> 1; const int agg = aR & 1; if (ac > 1022) ac = 1022;
    const bf16_t* asrc = KB + (size_t)(ac * 16) * 512 + (kv ? 384 : 0) + agg * 64 + aseg * 8;
    const bf16_t* bsrc = W1t + (size_t)(tid >> 3) * 2048 + (tid & 7) * 8;
    u32x4 bregX[4], aregX, bregY[4], aregY; f32x4 pe0X, pe1X, pe0Y, pe1Y;
#define CMP_LOAD(s_, breg, areg, pe0, pe1) do { _Pragma("unroll") for (int j = 0; j < 4; ++j) breg[j] = *(const u32x4*)(bsrc + (size_t)j * 64 * 2048 + (s_) * 64); \
        if (tid < 256) { areg = *(const u32x4*)(asrc + (size_t)(s_) * 512); pe0 = *(const f32x4*)(pe + (s_) * 64 + aseg * 8); pe1 = *(const f32x4*)(pe + (s_) * 64 + aseg * 8 + 4); } } while (0)
#define CMP_STORE(buf_, breg, areg, pe0, pe1) do { _Pragma("unroll") for (int j = 0; j < 4; ++j) *(LAS u32x4*)(lds + BS_OFF + (buf_) * BS_BYTES + ((tid >> 3) + 64 * j) * 144 + (tid & 7) * 16) = breg[j]; \
        if (tid < 256) { u32x4 aw; aw.x = cvt_pk_bf16(bflo(areg.x) + pe0.x, bfhi(areg.x) + pe0.y); aw.y = cvt_pk_bf16(bflo(areg.y) + pe0.z, bfhi(areg.y) + pe0.w); \
            aw.z = cvt_pk_bf16(bflo(areg.z) + pe1.x, bfhi(areg.z) + pe1.y); aw.w = cvt_pk_bf16(bflo(areg.w) + pe1.z, bfhi(areg.w) + pe1.w); \
            *(LAS u32x4*)(lds + AS_OFF + (buf_) * AS_BYTES + ar * 144 + aseg * 16) = aw; } } while (0)
#define CMP_COMPUTE(buf_) do { \
        const LAS unsigned char* Ab = lds + AS_OFF + (buf_) * AS_BYTES + (rt * 16 + l15) * 144 + G * 16; \
        const LAS unsigned char* Bb = lds + BS_OFF + (buf_) * BS_BYTES + (cgp * 64 + l15) * 144 + G * 16; \
        _Pragma("unroll") for (int kc = 0; kc < 2; ++kc) { const bf16x8 afr = *(const LAS bf16x8*)(Ab + kc * 64); \
            _Pragma("unroll") for (int nt = 0; nt < 4; ++nt) { const bf16x8 bfr = *(const LAS bf16x8*)(Bb + nt * 16 * 144 + kc * 64); \
                acc[nt] = __builtin_amdgcn_mfma_f32_16x16x32_bf16(afr, bfr, acc[nt], 0, 0, 0); } } } while (0)
    __syncthreads();
    CMP_LOAD(0, bregX, aregX, pe0X, pe1X); CMP_LOAD(1, bregY, aregY, pe0Y, pe1Y);
    CMP_STORE(0, bregX, aregX, pe0X, pe1X);
    __syncthreads();
    for (int st = 0; st < 32; st += 2) {
        if (st + 2 < 32) CMP_LOAD(st + 2, bregX, aregX, pe0X, pe1X);
        CMP_COMPUTE(0);
        CMP_STORE(1, bregY, aregY, pe0Y, pe1Y);
        __syncthreads();
        if (st + 3 < 32) CMP_LOAD(st + 3, bregY, aregY, pe0Y, pe1Y);
        CMP_COMPUTE(1);
        if (st + 2 < 32) CMP_STORE(0, bregX, aregX, pe0X, pe1X);
        __syncthreads();
    }
#undef CMP_COMPUTE
#undef CMP_LOAD
#undef CMP_STORE
    LAS bf16_t* HID = (LAS bf16_t*)lds;
    __syncthreads();
#pragma unroll
    for (int nt = 0; nt < 4; ++nt)
#pragma unroll
        for (int r = 0; r < 4; ++r) { const float x = acc[nt][r]; const float y = 0.7978845608028654f * (x + 0.044715f * x * x * x); const float gl = x * frcp(1.f + fexp2(-2.f * LOG2E * y));
            HID[(rt * 16 + G * 4 + r) * 264 + cgp * 64 + nt * 16 + l15] = (bf16_t)(cvt_pk_bf16(gl, 0.f) & 0xffffu); }
    __syncthreads();
    const int dt = w & 3;
    f32x4 o = (f32x4){0.f, 0.f, 0.f, 0.f};
#pragma unroll
    for (int kk = 0; kk < 8; ++kk) {
        const bf16x8 a = *(const LAS bf16x8*)(HID + (rt * 16 + l15) * 264 + kk * 32 + G * 8);
        const bf16x8 b = *(const bf16x8*)(W2t + (size_t)(dt * 16 + l15) * 256 + kk * 32 + G * 8);
        o = __builtin_amdgcn_mfma_f32_16x16x32_bf16(a, b, o, 0, 0, 0);
    }
#pragma unroll
    for (int r = 0; r < 4; ++r) { const int Ro = item * 32 + rt * 16 + G * 4 + r, co = Ro >> 1, go = Ro & 1, d = dt * 16 + l15;
        const bf16_t val = (co > 1022) ? (bf16_t)0 : (bf16_t)(cvt_pk_bf16(o[r], 0.f) & 0xffffu);
        if (kv == 0) KC[(size_t)(co * 2 + go) * 64 + d] = val; else VCT[(size_t)(go * 64 + d) * 1024 + co] = val; }
    __syncthreads();
}

constexpr int A_PS = 0, A_SEL = 65536, A_R0 = 67584, A_QS = 92160;
#define GLDS16(gp, lp) __builtin_amdgcn_global_load_lds((const unsigned*)(gp), (LAS unsigned*)(lp), 16, 0, 0)
#define VMWAIT(n) asm volatile("s_waitcnt vmcnt(" #n ")" ::: "memory")
#define RAWBAR() __builtin_amdgcn_s_barrier()
template <int IPC, int D> __device__ __forceinline__ void ring_wait(int rem) {
    const int o = (rem < D - 1 ? rem : D - 1) * IPC;
    if (o >= 4) VMWAIT(4); else if (o == 3) VMWAIT(3); else if (o == 2) VMWAIT(2); else if (o == 1) VMWAIT(1); else VMWAIT(0);
}
__device__ __forceinline__ int swz(int r, int seg) { return r * 128 + ((seg ^ ((r >> 1) & 7)) << 4); }
__device__ __forceinline__ void qk64(const LAS unsigned char* Kst, int l15, int G, const LAS unsigned char* Qw, int ct, f32x4 (&s)[4]) {
    const int qr = ct * 16 + l15;
    const bf16x8 q0 = *(const LAS bf16x8*)(Qw + swz(qr, G)), q1 = *(const LAS bf16x8*)(Qw + swz(qr, 4 + G));
#pragma unroll
    for (int kt = 0; kt < 4; ++kt) {
        const int kr = kt * 16 + l15;
        const bf16x8 a0 = *(const LAS bf16x8*)(Kst + swz(kr, G)), a1 = *(const LAS bf16x8*)(Kst + swz(kr, 4 + G));
        f32x4 z = (f32x4){0.f, 0.f, 0.f, 0.f};
        z = __builtin_amdgcn_mfma_f32_16x16x32_bf16(a0, q0, z, 0, 0, 0);
        z = __builtin_amdgcn_mfma_f32_16x16x32_bf16(a1, q1, z, 0, 0, 0);
        s[kt] = z;
    }
}
__device__ __forceinline__ void pv64(const LAS unsigned char* Vst, int l15, int G, const f32x4 (&p)[4], f32x4 (&o)[4]) {
    u32x4 w0, w1;
    w0.x = cvt_pk_bf16(p[0][0], p[0][1]); w0.y = cvt_pk_bf16(p[0][2], p[0][3]); w0.z = cvt_pk_bf16(p[1][0], p[1][1]); w0.w = cvt_pk_bf16(p[1][2], p[1][3]);
    w1.x = cvt_pk_bf16(p[2][0], p[2][1]); w1.y = cvt_pk_bf16(p[2][2], p[2][3]); w1.z = cvt_pk_bf16(p[3][0], p[3][1]); w1.w = cvt_pk_bf16(p[3][2], p[3][3]);
    const bf16x8 p0 = __builtin_bit_cast(bf16x8, w0), p1 = __builtin_bit_cast(bf16x8, w1);
    const int hb = (G & 1) * 8, sg = G >> 1;
#pragma unroll
    for (int dt = 0; dt < 4; ++dt) {
        const int vr = dt * 16 + l15;
        u32x4 a0, a1;
        { const u32x2 x = *(const LAS u32x2*)(Vst + swz(vr, sg) + hb), y = *(const LAS u32x2*)(Vst + swz(vr, 2 + sg) + hb); a0.x = x.x; a0.y = x.y; a0.z = y.x; a0.w = y.y; }
        { const u32x2 x = *(const LAS u32x2*)(Vst + swz(vr, 4 + sg) + hb), y = *(const LAS u32x2*)(Vst + swz(vr, 6 + sg) + hb); a1.x = x.x; a1.y = x.y; a1.z = y.x; a1.w = y.y; }
        o[dt] = __builtin_amdgcn_mfma_f32_16x16x32_bf16(__builtin_bit_cast(bf16x8, a0), p0, o[dt], 0, 0, 0);
        o[dt] = __builtin_amdgcn_mfma_f32_16x16x32_bf16(__builtin_bit_cast(bf16x8, a1), p1, o[dt], 0, 0, 0);
    }
}
__device__ __forceinline__ void v_load(const LAS unsigned char* Vst, int l15, int G, u32x4 (&vf)[4][2]) {
    const int hb = (G & 1) * 8, sg = G >> 1;
#pragma unroll
    for (int dt = 0; dt < 4; ++dt) {
        const int vr = dt * 16 + l15;
        { const u32x2 x = *(const LAS u32x2*)(Vst + swz(vr, sg) + hb), y = *(const LAS u32x2*)(Vst + swz(vr, 2 + sg) + hb); vf[dt][0].x = x.x; vf[dt][0].y = x.y; vf[dt][0].z = y.x; vf[dt][0].w = y.y; }
        { const u32x2 x = *(const LAS u32x2*)(Vst + swz(vr, 4 + sg) + hb), y = *(const LAS u32x2*)(Vst + swz(vr, 6 + sg) + hb); vf[dt][1].x = x.x; vf[dt][1].y = x.y; vf[dt][1].z = y.x; vf[dt][1].w = y.y; }
    }
}
__device__ __forceinline__ void pv_mma(const u32x4 (&vf)[4][2], const f32x4 (&p)[4], f32x4 (&o)[4]) {
    u32x4 w0, w1;
    w0.x = cvt_pk_bf16(p[0][0], p[0][1]); w0.y = cvt_pk_bf16(p[0][2], p[0][3]); w0.z = cvt_pk_bf16(p[1][0], p[1][1]); w0.w = cvt_pk_bf16(p[1][2], p[1][3]);
    w1.x = cvt_pk_bf16(p[2][0], p[2][1]); w1.y = cvt_pk_bf16(p[2][2], p[2][3]); w1.z = cvt_pk_bf16(p[3][0], p[3][1]); w1.w = cvt_pk_bf16(p[3][2], p[3][3]);
    const bf16x8 p0 = __builtin_bit_cast(bf16x8, w0), p1 = __builtin_bit_cast(bf16x8, w1);
#pragma unroll
    for (int dt = 0; dt < 4; ++dt) {
        o[dt] = __builtin_amdgcn_mfma_f32_16x16x32_bf16(__builtin_bit_cast(bf16x8, vf[dt][0]), p0, o[dt], 0, 0, 0);
        o[dt] = __builtin_amdgcn_mfma_f32_16x16x32_bf16(__builtin_bit_cast(bf16x8, vf[dt][1]), p1, o[dt], 0, 0, 0);
    }
}
template <bool MASK> __device__ __forceinline__ float tile_max(const f32x4 (&s)[4], int lo, int hi) {
    float mx = -1e30f;
#pragma unroll
    for (int kt = 0; kt < 4; ++kt)
#pragma unroll
        for (int r = 0; r < 4; ++r) { float v = s[kt][r]; if (MASK) { const int c = kt * 16 + r; v = (c >= lo && c <= hi) ? v : -1e30f; } mx = fmaxf(mx, v); }
    return mx;
}
template <bool MASK> __device__ __forceinline__ float tile_exp(const f32x4 (&s)[4], int lo, int hi, float negm, f32x4 (&p)[4]) {
    f32x4 acc = (f32x4){0.f, 0.f, 0.f, 0.f};
#pragma unroll
    for (int kt = 0; kt < 4; ++kt) {
        const f32x4 t = s[kt] * SC + negm; f32x4 e;
#pragma unroll
        for (int r = 0; r < 4; ++r) { float x = fexp2(t[r]); if (MASK) { const int c = kt * 16 + r; x = (c >= lo && c <= hi) ? x : 0.f; } e[r] = x; }
        p[kt] = e; acc = acc + e;
    }
    return (acc[0] + acc[1]) + (acc[2] + acc[3]);
}
template <bool MASK> __device__ __forceinline__ void stats_body(const f32x4 (&s)[4], int lo, int hi, float& m, float& l) {
    const float mn = fmaxf(m, tile_max<MASK>(s, lo, hi) * SC);
    f32x4 p[4]; const float sum = tile_exp<MASK>(s, lo, hi, -mn, p);
    l = l * fexp2(m - mn) + sum; m = mn;
}
__device__ __forceinline__ void swap32(float& a, float& b) { asm("s_nop 1\n\tv_permlane32_swap_b32 %0, %1\n\ts_nop 1" : "+v"(a), "+v"(b)); }
__device__ __forceinline__ void swap16(float& a, float& b) { asm("s_nop 1\n\tv_permlane16_swap_b32 %0, %1\n\ts_nop 1" : "+v"(a), "+v"(b)); }
__device__ __forceinline__ float xmax4(float v) {
    float a = v, b = v; swap32(a, b); v = fmaxf(a, b);
    a = v; b = v; swap16(a, b); return fmaxf(a, b);
}
__device__ __forceinline__ float xsum4(float v) {
    float a = v, b = v; swap32(a, b); v = a + b;
    a = v; b = v; swap16(a, b); return a + b;
}
#define DPPF(v, ctrl) __builtin_bit_cast(float, __builtin_amdgcn_update_dpp(0, __builtin_bit_cast(int, v), ctrl, 0xF, 0xF, true))
__device__ __forceinline__ float wave_max64(float v) {
    v = fmaxf(v, DPPF(v, 0xB1)); v = fmaxf(v, DPPF(v, 0x4E)); v = fmaxf(v, DPPF(v, 0x141)); v = fmaxf(v, DPPF(v, 0x128));
    return xmax4(v);
}
__device__ __forceinline__ float dpp_sum8(float v) {
    v += __builtin_bit_cast(float, __builtin_amdgcn_update_dpp(0, __builtin_bit_cast(int, v), 0xB1, 0xF, 0xF, true));
    v += __builtin_bit_cast(float, __builtin_amdgcn_update_dpp(0, __builtin_bit_cast(int, v), 0x4E, 0xF, 0xF, true));
    v += __builtin_bit_cast(float, __builtin_amdgcn_update_dpp(0, __builtin_bit_cast(int, v), 0x141, 0xF, 0xF, true));
    return v;
}

__device__ __forceinline__ void attn_unit(LAS unsigned char* lds, const int g, const int cur, const bf16_t* KC, const bf16_t* VCT, const bf16_t* KB, const bf16_t* VT, const bf16_t* Q, bf16_t* OUT, const float* GS) {
    const int tid = threadIdx.x, lane = tid & 63, w = __builtin_amdgcn_readfirstlane(tid >> 6), l15 = lane & 15, G = lane >> 4;
    const int t0 = cur * 64, tq0 = t0 + 8 * w, qsub = l15 >> 3, h = l15 & 7;
    LAS float* PS = (LAS float*)(lds + A_PS); LAS unsigned* SEL = (LAS unsigned*)(lds + A_SEL);
    LAS float* STASH = (LAS float*)(lds + A_R0);
    LAS unsigned char* QW = lds + A_QS + w * 8192;
    const int srow = tid >> 3, sseg = (tid & 7) ^ ((srow >> 1) & 7);
    const unsigned wofs = (unsigned)w * 1024u;
#pragma unroll
    for (int i = 0; i < 8; ++i) { const int pc = i * 64 + lane, r = pc >> 3, seg = pc & 7;
        const u32x4 v = *(const u32x4*)(Q + (size_t)(tq0 + (r >> 3)) * D + (8 * g + (r & 7)) * 64 + seg * 8);
        *(LAS u32x4*)(QW + swz(r, seg)) = v; }
    const int nch = (((t0 + 32) >> 4) >> 6) + 1;
    const bf16_t* kc_src = KC + (size_t)g * 64 + (size_t)srow * 128 + sseg * 8;
    const bf16_t* vc_src = VCT + (size_t)(g * 64 + srow) * 1024 + sseg * 8;
    const bf16_t* ks_src = KB + (size_t)srow * 512 + 128 + g * 64 + sseg * 8;
    const bf16_t* vs_src = VT + (size_t)((0 * 2 + g) * 64 + srow) * M + sseg * 8;
    const bf16_t* kw_src = KB + (size_t)srow * 512 + 256 + g * 64 + sseg * 8;
    const bf16_t* vw_src = VT + (size_t)((1 * 2 + g) * 64 + srow) * M + sseg * 8;
    const int cmax_lo = tq0 >= 31 ? ((tq0 - 31) >> 4) : -1, cmax_hi = (tq0 + 7) >= 31 ? ((tq0 + 7 - 31) >> 4) : -1;
    asm volatile("s_waitcnt vmcnt(0) lgkmcnt(0)" ::: "memory");
    float mc[4], lc[4];
#pragma unroll
    for (int ct = 0; ct < 4; ++ct) { mc[ct] = -1e30f; lc[ct] = 0.f; }
    {
        LAS unsigned char* R0 = lds + A_R0;
        for (int j = 0; j < 2 && j < nch; ++j) GLDS16(kc_src + (size_t)j * 8192, R0 + j * 8192 + wofs);
        for (int ch = 0; ch < nch; ++ch) {
            ring_wait<1, 2>(nch - 1 - ch); RAWBAR();
            if (ch + 2 < nch) GLDS16(kc_src + (size_t)(ch + 2) * 8192, R0 + ((ch + 2) % 3) * 8192 + wofs);
            const LAS unsigned char* KST = R0 + (ch % 3) * 8192;
            if (ch * 64 > cmax_hi) continue;
            const bool full = (ch * 64 + 63 <= cmax_lo);
#pragma unroll
            for (int ct = 0; ct < 4; ++ct) {
                if ((ct & 1) == 0) __builtin_amdgcn_sched_barrier(0);
                f32x4 s[4]; qk64(KST, l15, G, QW, ct, s);
                if (full) stats_body<false>(s, 0, 0, mc[ct], lc[ct]);
                else { const int tcol = tq0 + 2 * ct + qsub; const int cmax = tcol >= 31 ? ((tcol - 31) >> 4) : -1;
                       stats_body<true>(s, 0, cmax - (ch * 64 + 4 * G), mc[ct], lc[ct]); }
            }
        }
        RAWBAR();
    }
#pragma unroll
    for (int ct = 0; ct < 4; ++ct) {
        const float m = xmax4(mc[ct]);
        const float l = xsum4(lc[ct] * fexp2(mc[ct] - m));
        mc[ct] = m; lc[ct] = l;
    }
    {
        LAS unsigned char* R0 = lds + A_R0;
        float carry[4] = {0.f, 0.f, 0.f, 0.f};
        float negm[4];
#pragma unroll
        for (int ct = 0; ct < 4; ++ct) negm[ct] = lc[ct] > 0.f ? __builtin_amdgcn_logf(1.f / lc[ct]) - mc[ct] : -1e30f;
        for (int j = 0; j < 2 && j < nch; ++j) GLDS16(kc_src + (size_t)j * 8192, R0 + j * 8192 + wofs);
        for (int ch = 0; ch < nch; ++ch) {
            ring_wait<1, 2>(nch - 1 - ch); RAWBAR();
            if (ch + 2 < nch) GLDS16(kc_src + (size_t)(ch + 2) * 8192, R0 + ((ch + 2) % 3) * 8192 + wofs);
            const LAS unsigned char* KST = R0 + (ch % 3) * 8192;
            const bool none = (ch * 64 > cmax_hi), full = (ch * 64 + 63 <= cmax_lo);
#pragma unroll
            for (int ct = 0; ct < 4; ++ct) {
                if ((ct & 1) == 0) __builtin_amdgcn_sched_barrier(0);
                f32x4 p[4];
                if (none) {
#pragma unroll
                    for (int kt = 0; kt < 4; ++kt) p[kt] = (f32x4){0.f, 0.f, 0.f, 0.f};
                } else {
                    f32x4 s[4]; qk64(KST, l15, G, QW, ct, s);
                    if (full) tile_exp<false>(s, 0, 0, negm[ct], p);
                    else { const int tcol = tq0 + 2 * ct + qsub; const int cmax = tcol >= 31 ? ((tcol - 31) >> 4) : -1; tile_exp<true>(s, 0, cmax - (ch * 64 + 4 * G), negm[ct], p); }
                }
                float prev = carry[ct];
#pragma unroll
                for (int kt = 0; kt < 4; ++kt) {
                    const float gsum = dpp_sum8((p[kt][0] + p[kt][1]) + (p[kt][2] + p[kt][3])), last = dpp_sum8(p[kt][3]);
                    const float send = (G == 3) ? prev : last;
                    const float recv = __shfl(send, (lane + 48) & 63);
                    const int n = ch * 16 + kt * 4 + G;
                    if (h == 0) PS[(8 * w + 2 * ct + qsub) * 256 + n] = gsum + recv;
                    prev = last;
                }
                carry[ct] = prev;
            }
        }
    }
    __syncthreads();
    {
        const int ksel = cur + 1 < 16 ? cur + 1 : 16;
        unsigned act0 = 0, act1 = 0, act2 = 0, act3 = 0;
        for (int qi = 0; qi < 8; ++qi) {
            const int q = 8 * w + qi;
            float v0, v1, v2, v3;
            { const int n0 = lane, n1 = lane + 64, n2 = lane + 128, n3 = lane + 192;
              v0 = n0 <= cur ? PS[q * 256 + n0] : -2.f; v1 = n1 <= cur ? PS[q * 256 + n1] : -2.f; v2 = n2 <= cur ? PS[q * 256 + n2] : -2.f; v3 = n3 <= cur ? PS[q * 256 + n3] : -2.f;
              if (n0 == 0 || n0 == cur || n0 == cur - 1) v0 = 1e9f;
              if (n1 == cur || n1 == cur - 1) v1 = 1e9f;
              if (n2 == cur || n2 == cur - 1) v2 = 1e9f;
              if (n3 == cur || n3 == cur - 1) v3 = 1e9f; }
            unsigned taken = 0;
            for (int it = 0; it < ksel; ++it) {
                const float lm = fmaxf(fmaxf(v0, v1), fmaxf(v2, v3));
                const float wm = wave_max64(lm);
                const unsigned long long bal = __ballot(lm == wm);
                const int first = __ffsll((long long)bal) - 1;
                if (lane == first) {
                    if (v0 == wm) { v0 = -3.f; taken |= 1u; }
                    else if (v1 == wm) { v1 = -3.f; taken |= 2u; }
                    else if (v2 == wm) { v2 = -3.f; taken |= 4u; }
                    else { v3 = -3.f; taken |= 8u; }
                }
            }
            act0 |= ((taken >> 0) & 1u) << qi; act1 |= ((taken >> 1) & 1u) << qi; act2 |= ((taken >> 2) & 1u) << qi; act3 |= ((taken >> 3) & 1u) << qi;
        }
        LAS unsigned char* ACT = (LAS unsigned char*)SEL + w * 256;
        ACT[lane] = (unsigned char)act0; ACT[lane + 64] = (unsigned char)act1; ACT[lane + 128] = (unsigned char)act2; ACT[lane + 192] = (unsigned char)act3;
    }
#pragma unroll
    for (int ct = 0; ct < 4; ++ct) { STASH[(ct * 2 + 0) * 512 + tid] = mc[ct]; STASH[(ct * 2 + 1) * 512 + tid] = lc[ct]; }
    __syncthreads();
    LAS unsigned char* RG = lds + A_PS;
    f32x4 O[4][4];
#pragma unroll
    for (int ct = 0; ct < 4; ++ct)
#pragma unroll
        for (int dt = 0; dt < 4; ++dt) O[ct][dt] = (f32x4){0.f, 0.f, 0.f, 0.f};
    {
        float ms[4], ls[4];
#pragma unroll
        for (int ct = 0; ct < 4; ++ct) { ms[ct] = -1e30f; ls[ct] = 0.f; }
        const int nb = cur + 1;
#define SLC_ISSUE(nn) do { GLDS16(ks_src + (size_t)(nn) * 64 * 512, RG + ((nn) & 3) * 16384 + wofs); GLDS16(vs_src + (size_t)(nn) * 64, RG + ((nn) & 3) * 16384 + 8192 + wofs); } while (0)
        SLC_ISSUE(0); if (nb > 1) SLC_ISSUE(1);
        const LAS unsigned char* ACTW = (const LAS unsigned char*)SEL + w * 256;
        for (int n2 = 0; n2 < nb; n2 += 2) {
            const unsigned act2 = (unsigned)__builtin_amdgcn_readfirstlane((int)*(const LAS unsigned short*)(ACTW + n2));
            VMWAIT(0); RAWBAR();
            if (n2 + 2 < nb) SLC_ISSUE(n2 + 2);
            if (n2 + 3 < nb) SLC_ISSUE(n2 + 3);
          for (int n = n2; n < n2 + 2 && n < nb; ++n) {
            const unsigned actn = (act2 >> (8 * (n - n2))) & 0xffu;
            const LAS unsigned char* KST = RG + (n & 3) * 16384; const LAS unsigned char* VST = KST + 8192;
#pragma unroll
            for (int ct = 0; ct < 4; ++ct) {
                __builtin_amdgcn_sched_barrier(0);
                const unsigned bA = (actn >> (2 * ct)) & 1u, bB = (actn >> (2 * ct + 1)) & 1u;
                if (!(bA | bB)) continue;
                f32x4 s[4]; qk64(KST, l15, G, QW, ct, s);
                u32x4 vf[4][2]; v_load(VST, l15, G, vf);
                f32x4 p[4]; float mx, sum;
                const bool posmask = (n >= cur);
                const bool colsel = qsub ? (bB != 0) : (bA != 0);
                int hi = 0;
                if (!posmask) { mx = tile_max<false>(s, 0, 0); mx = colsel ? mx : -1e30f; }
                else { const int tcol = tq0 + 2 * ct + qsub; hi = colsel ? tcol - (64 * n + 4 * G) : -1; mx = tile_max<true>(s, 0, hi); }
                if (__any((ms[ct] < -1e29f) | (mx * SC > ms[ct] + 60.f))) {
                    const float mn = fmaxf(ms[ct], xmax4(mx) * SC), alpha = fexp2(ms[ct] - mn); ms[ct] = mn; ls[ct] *= alpha;
#pragma unroll
                    for (int dt = 0; dt < 4; ++dt) O[ct][dt] = O[ct][dt] * alpha;
                }
                if (!posmask) sum = tile_exp<false>(s, 0, 0, colsel ? -ms[ct] : -1e30f, p);
                else sum = tile_exp<true>(s, 0, hi, -ms[ct], p);
                ls[ct] += sum;
                pv_mma(vf, p, O[ct]);
                if (__any(mx * SC > ms[ct] + 8.f)) {
                    const float mxs = xmax4(mx) * SC;
                    {
                        const float mn = fmaxf(ms[ct], mxs), alpha = fexp2(ms[ct] - mn); ms[ct] = mn; ls[ct] *= alpha;
#pragma unroll
                        for (int dt = 0; dt < 4; ++dt) O[ct][dt] = O[ct][dt] * alpha;
                    }
                }
            }
          }
        }
#undef SLC_ISSUE
        RAWBAR();
#pragma unroll
        for (int ct = 0; ct < 4; ++ct) {
            const float l = xsum4(ls[ct]);
            const int tcol = tq0 + 2 * ct + qsub;
            const float gate = GS[(size_t)tcol * 48 + (8 * g + h) * 3 + 1];
            const float sc = l > 0.f ? gate / l : 0.f;
#pragma unroll
            for (int dt = 0; dt < 4; ++dt) O[ct][dt] = O[ct][dt] * sc;
        }
    }
    {
        float negm[4];
#pragma unroll
        for (int ct = 0; ct < 4; ++ct) { mc[ct] = STASH[(ct * 2 + 0) * 512 + tid]; lc[ct] = STASH[(ct * 2 + 1) * 512 + tid]; }
#pragma unroll
        for (int ct = 0; ct < 4; ++ct) { const int tcol = tq0 + 2 * ct + qsub; const float gt = GS[(size_t)tcol * 48 + (8 * g + h) * 3 + 0];
            negm[ct] = lc[ct] > 0.f ? __builtin_amdgcn_logf(gt / lc[ct]) - mc[ct] : -1e30f; }
        asm volatile("s_waitcnt vmcnt(0)" ::: "memory");
        for (int j = 0; j < 3 && j < nch; ++j) { GLDS16(kc_src + (size_t)j * 8192, RG + j * 16384 + wofs); GLDS16(vc_src + (size_t)j * 64, RG + j * 16384 + 8192 + wofs); }
        for (int ch = 0; ch < nch; ++ch) {
            ring_wait<2, 3>(nch - 1 - ch); RAWBAR();
            if (ch + 3 < nch) { GLDS16(kc_src + (size_t)(ch + 3) * 8192, RG + ((ch + 3) & 3) * 16384 + wofs); GLDS16(vc_src + (size_t)(ch + 3) * 64, RG + ((ch + 3) & 3) * 16384 + 8192 + wofs); }
            const LAS unsigned char* KST = RG + (ch & 3) * 16384; const LAS unsigned char* VST = KST + 8192;
            if (ch * 64 > cmax_hi) continue;
            const bool full = (ch * 64 + 63 <= cmax_lo);
#pragma unroll
            for (int ct = 0; ct < 4; ++ct) {
                if ((ct & 1) == 0) __builtin_amdgcn_sched_barrier(0);
                f32x4 s[4]; qk64(KST, l15, G, QW, ct, s);
                f32x4 p[4];
                if (full) tile_exp<false>(s, 0, 0, negm[ct], p);
                else { const int tcol = tq0 + 2 * ct + qsub; const int cmax = tcol >= 31 ? ((tcol - 31) >> 4) : -1; tile_exp<true>(s, 0, cmax - (ch * 64 + 4 * G), negm[ct], p); }
                pv64(VST, l15, G, p, O[ct]);
            }
        }
        RAWBAR();
    }
    {
        const int i0 = cur >= 8 ? 0 : 8 - cur, nw = 9 - i0, tkb = t0 - 512 + 64 * i0;
        float mw[4], lw[4];
#pragma unroll
        for (int ct = 0; ct < 4; ++ct) { mw[ct] = -1e30f; lw[ct] = 0.f; }
        for (int j = 0; j < 3 && j < nw; ++j) GLDS16(kw_src + (size_t)(tkb + 64 * j) * 512, RG + j * 16384 + wofs);
        for (int i = 0; i < nw; ++i) {
            ring_wait<1, 3>(nw - 1 - i); RAWBAR();
            if (i + 3 < nw) GLDS16(kw_src + (size_t)(tkb + 64 * (i + 3)) * 512, RG + ((i + 3) & 3) * 16384 + wofs);
            const LAS unsigned char* KST = RG + (i & 3) * 16384; const int tk0 = tkb + 64 * i;
            if (tk0 > tq0 + 7 || tk0 + 63 <= tq0 - 512) continue;
            const bool full = (tk0 + 63 <= tq0) && (tk0 > tq0 + 7 - 512);
#pragma unroll
            for (int ct = 0; ct < 4; ++ct) {
                if ((ct & 1) == 0) __builtin_amdgcn_sched_barrier(0);
                f32x4 s[4]; qk64(KST, l15, G, QW, ct, s);
                if (full) stats_body<false>(s, 0, 0, mw[ct], lw[ct]);
                else { const int tcol = tq0 + 2 * ct + qsub, b0 = tk0 + 4 * G; stats_body<true>(s, tcol - 511 - b0, tcol - b0, mw[ct], lw[ct]); }
            }
        }
        RAWBAR();
        float negm[4];
#pragma unroll
        for (int ct = 0; ct < 4; ++ct) {
            const float m = xmax4(mw[ct]);
            const float l = xsum4(lw[ct] * fexp2(mw[ct] - m));
            const int tcol = tq0 + 2 * ct + qsub;
            const float gt = GS[(size_t)tcol * 48 + (8 * g + h) * 3 + 2];
            negm[ct] = l > 0.f ? __builtin_amdgcn_logf(gt / l) - m : -1e30f;
        }
        asm volatile("s_waitcnt vmcnt(0)" ::: "memory");
        for (int j = 0; j < 3 && j < nw; ++j) { GLDS16(kw_src + (size_t)(tkb + 64 * j) * 512, RG + j * 16384 + wofs); GLDS16(vw_src + (size_t)(tkb + 64 * j), RG + j * 16384 + 8192 + wofs); }
        for (int i = 0; i < nw; ++i) {
            ring_wait<2, 3>(nw - 1 - i); RAWBAR();
            if (i + 3 < nw) { GLDS16(kw_src + (size_t)(tkb + 64 * (i + 3)) * 512, RG + ((i + 3) & 3) * 16384 + wofs); GLDS16(vw_src + (size_t)(tkb + 64 * (i + 3)), RG + ((i + 3) & 3) * 16384 + 8192 + wofs); }
            const LAS unsigned char* KST = RG + (i & 3) * 16384; const LAS unsigned char* VST = KST + 8192; const int tk0 = tkb + 64 * i;
            if (tk0 > tq0 + 7 || tk0 + 63 <= tq0 - 512) continue;
            const bool full = (tk0 + 63 <= tq0) && (tk0 > tq0 + 7 - 512);
#pragma unroll
            for (int ct = 0; ct < 4; ++ct) {
                if ((ct & 1) == 0) __builtin_amdgcn_sched_barrier(0);
                f32x4 s[4]; qk64(KST, l15, G, QW, ct, s);
                f32x4 p[4];
                if (full) tile_exp<false>(s, 0, 0, negm[ct], p);
                else { const int tcol = tq0 + 2 * ct + qsub, b0 = tk0 + 4 * G; tile_exp<true>(s, tcol - 511 - b0, tcol - b0, negm[ct], p); }
                pv64(VST, l15, G, p, O[ct]);
            }
        }
    }
#pragma unroll
    for (int ct = 0; ct < 4; ++ct) {
        bf16_t* op = OUT + (size_t)(tq0 + 2 * ct + qsub) * D + (8 * g + h) * 64 + 4 * G;
#pragma unroll
        for (int dt = 0; dt < 4; ++dt) { u32x2 wv; wv.x = cvt_pk_bf16(O[ct][dt][0], O[ct][dt][1]); wv.y = cvt_pk_bf16(O[ct][dt][2], O[ct][dt][3]); *(u32x2*)(op + dt * 16) = wv; }
    }
    asm volatile("s_waitcnt vmcnt(0) lgkmcnt(0)" ::: "memory");
    __syncthreads();
}

__global__ void __launch_bounds__(NTHREADS, 2) nsa_fwd(Args args) {
    extern __shared__ __attribute__((aligned(16))) unsigned char lds_raw[];
    LAS unsigned char* lds = (LAS unsigned char*)lds_raw;
    cg::grid_group grid = cg::this_grid();
    const int tid = threadIdx.x, lane = tid & 63, wave = __builtin_amdgcn_readfirstlane(tid >> 6);
    const int GSZ = gridDim.x, bid = blockIdx.x;
    const int gw = bid * NWAVES + wave, NGW = GSZ * NWAVES;
    unsigned char* ws = args.ws;
    const float* x = args.in[0];
    float* out = args.out;
    float* SSQ = (float*)(ws + WS_SSQ);
    const int lo = args.ph_lo, hi = args.ph_hi;
#ifndef PH_MASK
#define PH_MASK 0x7ff
#endif
#define IN(k) (((PH_MASK >> (k)) & 1) && lo <= (k) && (k) < hi)
#define SEAM(k) do { if (IN(k) && IN((k) + 1)) { \
        asm volatile("s_waitcnt vmcnt(0) lgkmcnt(0)" ::: "memory");        \
        __syncthreads(); \
        if (tid == 0) { \
            unsigned* ctr = (unsigned*)(ws + WS_CTL) + 64 * (k); \
            __builtin_amdgcn_fence(__ATOMIC_RELEASE, "agent"); asm volatile("s_waitcnt vmcnt(0)" ::: "memory");        \
            __hip_atomic_fetch_add(ctr, 1u, __ATOMIC_RELAXED, __HIP_MEMORY_SCOPE_AGENT); \
            while (__hip_atomic_load(ctr, __ATOMIC_RELAXED, __HIP_MEMORY_SCOPE_AGENT) < (unsigned)GSZ) __builtin_amdgcn_s_sleep(2); \
            __builtin_amdgcn_fence(__ATOMIC_ACQUIRE, "agent"); asm volatile("s_waitcnt vmcnt(0)" ::: "memory");        \
        } \
        __syncthreads(); } } while (0)

    grid.sync();
    if (IN(0)) {
        LAS float* scr = (LAS float*)(lds + wave * 16384);
        constexpr int I_UP = 16 * 176, I_DN = 44 * 32, I_WIN = 16 * 224, I_C1 = 32 * 8, I_C2 = 4 * 2;
        constexpr int NIT = I_UP + I_DN + I_WIN + 2 * I_C1 + 2 * I_C2;
        for (int it = gw; it < NIT; it += NGW) {
            int r = it;
            if (r < I_UP) { conv_ffn_up_item(args.in[2], args.in[3], args.in[1], (bf16_t*)(ws + WS_W1A), r, scr, lane); continue; } r -= I_UP;
            if (r < I_DN) { const int kb = r / 32, nb = r % 32; tr_item(args.in[4], FF, D, nb * 32, 32, nullptr, (bf16_t*)(ws + WS_W1D), nb * 32, kb * 64, scr, lane); continue; } r -= I_DN;
            if (r < I_WIN) { const int kb = r / 224, nb = r % 224; int nv; const int sc = win_src(nb * 32, nv); tr_item(args.in[6], D, IN_TOTAL, sc, nv, args.in[5], (bf16_t*)(ws + WS_WIN), nb * 32, kb * 64, scr, lane); continue; } r -= I_WIN;
            if (r < I_C1) { const int kb = r / 8, nb = r % 8; tr_item(args.in[9], 2048, 256, nb * 32, 32, nullptr, (bf16_t*)(ws + WS_WK1), nb * 32, kb * 64, scr, lane); continue; } r -= I_C1;
            if (r < I_C1) { const int kb = r / 8, nb = r % 8; tr_item(args.in[11], 2048, 256, nb * 32, 32, nullptr, (bf16_t*)(ws + WS_WV1), nb * 32, kb * 64, scr, lane); continue; } r -= I_C1;
            if (r < I_C2) { const int kb = r / 2, nb = r % 2; tr_item(args.in[10], 256, 64, nb * 32, 32, nullptr, (bf16_t*)(ws + WS_WK2), nb * 32, kb * 64, scr, lane); continue; } r -= I_C2;
            { const int kb = r / 2, nb = r % 2; tr_item(args.in[12], 256, 64, nb * 32, 32, nullptr, (bf16_t*)(ws + WS_WV2), nb * 32, kb * 64, scr, lane); }
        }
        bf16_t* XB = (bf16_t*)(ws + WS_XB);
        for (int m = gw; m < M; m += 2 * NGW) {
            const int m2 = m + NGW;
            const f32x4* xr = (const f32x4*)(x + (size_t)m * D) + lane; const f32x4* xr2 = (const f32x4*)(x + (size_t)(m2 < M ? m2 : m) * D) + lane;
            f32x4 va[4], vb[4];
#pragma unroll
            for (int j = 0; j < 4; ++j) { va[j] = __builtin_nontemporal_load(xr + 64 * j); vb[j] = __builtin_nontemporal_load(xr2 + 64 * j); }
            float s = 0.f, s2 = 0.f;
            unsigned long long* o8 = (unsigned long long*)(XB + (size_t)m * D) + lane; unsigned long long* o82 = (unsigned long long*)(XB + (size_t)(m2 < M ? m2 : m) * D) + lane;
#pragma unroll
            for (int j = 0; j < 4; ++j) { const f32x4 v = va[j]; s += (v.x * v.x + v.y * v.y) + (v.z * v.z + v.w * v.w);
                o8[64 * j] = (unsigned long long)cvt_pk_bf16(v.x, v.y) | ((unsigned long long)cvt_pk_bf16(v.z, v.w) << 32); }
            s = wave_sum(s);
            if (lane == 0) ((float*)(ws + WS_RS0))[m] = s;
            if (m2 < M) {
#pragma unroll
                for (int j = 0; j < 4; ++j) { const f32x4 v = vb[j]; s2 += (v.x * v.x + v.y * v.y) + (v.z * v.z + v.w * v.w);
                    o82[64 * j] = (unsigned long long)cvt_pk_bf16(v.x, v.y) | ((unsigned long long)cvt_pk_bf16(v.z, v.w) << 32); }
                s2 = wave_sum(s2);
                if (lane == 0) ((float*)(ws + WS_RS0))[m2] = s2;
            }
        }
    }
    SEAM(0);
    if (IN(1)) {
        pg8::Gemm g{(const bf16_t*)(ws + WS_XB), (const bf16_t*)(ws + WS_W1A), M, 2 * FF, D}; pg8::StaticOrder S; S.init(M, 2 * FF, GSZ, bid);
        pg8::EpiSwiglu E{(bf16_t*)(ws + WS_HB), (const float*)(ws + WS_RS0)};
        pg8::gemm_phase(lds, g, S, E);
    }
    SEAM(1);
    if (IN(2)) {
        pg8::Gemm g{(const bf16_t*)(ws + WS_HB), (const bf16_t*)(ws + WS_W1D), M, D, FF}; pg8::StaticOrder S; S.init(M, D, GSZ, bid);
        pg8::EpiRes E{x, out, (bf16_t*)(ws + WS_XB), (float*)(ws + WS_RSA), 0.5f};
        pg8::gemm_phase(lds, g, S, E);
    }
    SEAM(2);
    if (IN(3)) {
        pg8::Gemm g{(const bf16_t*)(ws + WS_XB), (const bf16_t*)(ws + WS_WIN), M, NP, D}; pg8::StaticOrder S; S.init(M, NP, GSZ, bid);
        pg8::EpiWin E{ws, (const float*)(ws + WS_RSA)};
        pg8::gemm_phase(lds, g, S, E);
    }
    SEAM(3);
    if (IN(4)) {
        for (int it = bid; it < 128; it += GSZ) {
            const int kv = it & 1, item = it >> 1;
            compress_item(lds, item, (const bf16_t*)(ws + WS_KB), kv ? args.in[8] : args.in[7], (const bf16_t*)(ws + (kv ? WS_WV1 : WS_WK1)), (const bf16_t*)(ws + (kv ? WS_WV2 : WS_WK2)),
                          (bf16_t*)(ws + WS_KC), (bf16_t*)(ws + WS_VCT), kv);
        }
        {
            const float* cw = args.in[13];
            bf16_t* CB = (bf16_t*)(ws + WS_CB); const bf16_t* CU = (const bf16_t*)(ws + WS_CU);
            const bool split = (GSZ >= 256);
            const int cw_first = split ? 128 : 0, cw_n = GSZ - cw_first;
            if (bid >= cw_first)
            for (int it = (bid - cw_first) * NTHREADS + tid; it < (M / 8) * 128; it += cw_n * NTHREADS) {
                const int cv = it & 127, tb = it >> 7, ch0 = cv * 8, ts = tb * 8;
                u32x4 uu[10], bb[8];
#pragma unroll
                for (int i = 0; i < 10; ++i) { const int t = ts - 2 + i; uu[i] = (t >= 0) ? __builtin_nontemporal_load((const u32x4*)(CU + (size_t)t * D + ch0)) : (u32x4){0u, 0u, 0u, 0u}; }
#pragma unroll
                for (int i = 0; i < 8; ++i) bb[i] = __builtin_nontemporal_load((const u32x4*)(CB + (size_t)(ts + i) * D + ch0));
                float w0[8], w1[8], w2[8];
#pragma unroll
                for (int i = 0; i < 8; ++i) { w0[i] = cw[ch0 + i]; w1[i] = cw[1024 + ch0 + i]; w2[i] = cw[2048 + ch0 + i]; }
#pragma unroll
                for (int tt = 0; tt < 8; ++tt) {
                    const u32x4 a = uu[tt], b = uu[tt + 1], c = uu[tt + 2], bv = bb[tt];
                    float y[8];
                    y[0] = bflo(bv.x) * (w0[0] * bflo(a.x) + w1[0] * bflo(b.x) + w2[0] * bflo(c.x)); y[1] = bfhi(bv.x) * (w0[1] * bfhi(a.x) + w1[1] * bfhi(b.x) + w2[1] * bfhi(c.x));
                    y[2] = bflo(bv.y) * (w0[2] * bflo(a.y) + w1[2] * bflo(b.y) + w2[2] * bflo(c.y)); y[3] = bfhi(bv.y) * (w0[3] * bfhi(a.y) + w1[3] * bfhi(b.y) + w2[3] * bfhi(c.y));
                    y[4] = bflo(bv.z) * (w0[4] * bflo(a.z) + w1[4] * bflo(b.z) + w2[4] * bflo(c.z)); y[5] = bfhi(bv.z) * (w0[5] * bfhi(a.z) + w1[5] * bfhi(b.z) + w2[5] * bfhi(c.z));
                    y[6] = bflo(bv.w) * (w0[6] * bflo(a.w) + w1[6] * bflo(b.w) + w2[6] * bflo(c.w)); y[7] = bfhi(bv.w) * (w0[7] * bfhi(a.w) + w1[7] * bfhi(b.w) + w2[7] * bfhi(c.w));
                    u32x4 o; o.x = cvt_pk_bf16(y[0], y[1]); o.y = cvt_pk_bf16(y[2], y[3]); o.z = cvt_pk_bf16(y[4], y[5]); o.w = cvt_pk_bf16(y[6], y[7]);
                    *(u32x4*)(CB + (size_t)(ts + tt) * D + ch0) = o;
                }
            }
        }
        {
            __syncthreads();
            LAS float* scr = (LAS float*)(lds + wave * 16384);
            constexpr int I_SQ = 16 * 32, I_UP = 16 * 176, I_DN = 44 * 32;
            constexpr int NIT = 3 * I_SQ + I_UP + I_DN;
            for (int it = gw; it < NIT; it += NGW) {
                int r = it;
                if (r < I_SQ) { const int kb = r / 32, nb = r % 32; tr_item(args.in[14], D, D, nb * 32, 32, nullptr, (bf16_t*)(ws + WS_WNA), nb * 32, kb * 64, scr, lane); continue; } r -= I_SQ;
                if (r < I_SQ) { const int kb = r / 32, nb = r % 32; tr_item(args.in[15], D, D, nb * 32, 32, nullptr, (bf16_t*)(ws + WS_WCO), nb * 32, kb * 64, scr, lane); continue; } r -= I_SQ;
                if (r < I_SQ) { const int kb = r / 32, nb = r % 32; tr_item(args.in[16], D, D, nb * 32, 32, nullptr, (bf16_t*)(ws + WS_WO), nb * 32, kb * 64, scr, lane); continue; } r -= I_SQ;
                if (r < I_UP) { conv_ffn_up_item(args.in[18], args.in[19], args.in[17], (bf16_t*)(ws + WS_W2A), r, scr, lane); continue; } r -= I_UP;
                { const int kb = r / 32, nb = r % 32; tr_item(args.in[20], FF, D, nb * 32, 32, nullptr, (bf16_t*)(ws + WS_W2D), nb * 32, kb * 64, scr, lane); }
            }
            __syncthreads();
        }
    }
    SEAM(4);
    if (IN(5)) {
        for (int p2 = bid; p2 < 512; p2 += GSZ) {
            const int p = p2 & 255, g = p & 1, xq = p >> 1;
            const int cur = (p2 < 256) ? 255 - xq : xq;
            attn_unit(lds, g, cur, (const bf16_t*)(ws + WS_KC), (const bf16_t*)(ws + WS_VCT), (const bf16_t*)(ws + WS_KB), (const bf16_t*)(ws + WS_VT), (const bf16_t*)(ws + WS_QO), (bf16_t*)(ws + WS_QO), (const float*)(ws + WS_G));
        }
    }
    SEAM(5);
    if (IN(6)) {
        { pg8::Gemm g{(const bf16_t*)(ws + WS_QO), (const bf16_t*)(ws + WS_WNA), M, D, D}; pg8::StaticOrder S; S.init(M, D, GSZ, bid);
          pg8::EpiMerge<0> E{(bf16_t*)(ws + WS_GA), (const bf16_t*)(ws + WS_GA)}; pg8::gemm_phase(lds, g, S, E); }
        { pg8::Gemm g{(const bf16_t*)(ws + WS_CB), (const bf16_t*)(ws + WS_WCO), M, D, D}; pg8::StaticOrder S; S.init(M, D, GSZ, bid);
          pg8::EpiMerge<1> E{(bf16_t*)(ws + WS_GA), (const bf16_t*)(ws + WS_GB)}; pg8::gemm_phase(lds, g, S, E); }
    }
    SEAM(6);
    if (IN(7)) {
        pg8::Gemm g{(const bf16_t*)(ws + WS_GA), (const bf16_t*)(ws + WS_WO), M, D, D}; pg8::StaticOrder S; S.init(M, D, GSZ, bid);
        pg8::EpiRes E{out, out, (bf16_t*)(ws + WS_QO), (float*)(ws + WS_RSB), 1.0f};
        pg8::gemm_phase(lds, g, S, E);
    }
    SEAM(7);
    if (IN(8)) {
        pg8::Gemm g{(const bf16_t*)(ws + WS_QO), (const bf16_t*)(ws + WS_W2A), M, 2 * FF, D}; pg8::StaticOrder S; S.init(M, 2 * FF, GSZ, bid);
        pg8::EpiSwiglu E{(bf16_t*)(ws + WS_HB), (const float*)(ws + WS_RSB)};
        pg8::gemm_phase(lds, g, S, E);
    }
    SEAM(8);
    const bool fused_final = (GSZ == 256);
    if (IN(9)) {
        pg8::Gemm g{(const bf16_t*)(ws + WS_HB), (const bf16_t*)(ws + WS_W2D), M, D, FF}; pg8::StaticOrder S; S.init(M, D, GSZ, bid);
        if (fused_final) { pg8::EpiFinal E{out, (float*)(ws + WS_RSC), (unsigned*)(ws + WS_PCNT), args.in[21]}; pg8::gemm_phase(lds, g, S, E); }
        else { pg8::EpiRes E{out, out, nullptr, nullptr, 0.5f}; pg8::gemm_phase(lds, g, S, E); }
    }
    if (!fused_final) {
    SEAM(9);
    if (IN(10)) {
        const float* gn = args.in[21];
        for (int m = gw; m < M; m += NGW) {
            f32x4* xr = (f32x4*)(out + (size_t)m * D) + lane; const f32x4* gr = (const f32x4*)gn + lane;
            f32x4 v[4]; float ss = 0.f;
#pragma unroll
            for (int j = 0; j < 4; ++j) { v[j] = xr[64 * j]; ss += (v[j].x * v[j].x + v[j].y * v[j].y) + (v[j].z * v[j].z + v[j].w * v[j].w); }
            const float rs = rsqrtf(wave_sum(ss) * (1.f / 1024.f) + EPS);
#pragma unroll
            for (int j = 0; j < 4; ++j) { const f32x4 gg = gr[64 * j]; xr[64 * j] = v[j] * rs * gg; }
        }
    }
    }
#undef IN
#undef SEAM
}

extern "C" void kernel_launch(void* const* d_in, const int* in_sizes, int n_in, void* d_out, int out_size, void* d_ws, size_t ws_size, hipStream_t stream) {
    static int grid = 0;
    if (grid == 0) {
        if (n_in != 22 || out_size != M * D || ws_size < WS_END) { fprintf(stderr, "kernel_launch: unexpected problem (n_in %d out %d ws %zu)\n", n_in, out_size, ws_size); grid = -1; return; }
        int dev = 0, cus = 0, per_cu = 0;
        hipGetDevice(&dev); hipDeviceGetAttribute(&cus, hipDeviceAttributeMultiprocessorCount, dev);
        if (hipFuncSetAttribute((const void*)nsa_fwd, hipFuncAttributeMaxDynamicSharedMemorySize, LDS_BYTES) != hipSuccess) { fprintf(stderr, "kernel_launch: hipFuncSetAttribute failed\n"); grid = -1; return; }
        hipOccupancyMaxActiveBlocksPerMultiprocessor(&per_cu, (const void*)nsa_fwd, NTHREADS, LDS_BYTES);
        (void)hipGetLastError();
        if (per_cu < 1) per_cu = 1;
        grid = cus;
    }
    if (grid < 0) return;
    if (hipMemsetAsync((char*)d_ws + WS_CTL, 0, CTL_BYTES, stream) != hipSuccess) { fprintf(stderr, "kernel_launch: memset failed\n"); return; }
    Args a{};
    for (int i = 0; i < 22; ++i) a.in[i] = (const float*)d_in[i];
    a.out = (float*)d_out; a.ws = (unsigned char*)d_ws;
#if MK_PER_PHASE
    for (int ph = 0; ph < 11; ++ph) {
        a.ph_lo = ph; a.ph_hi = ph + 1;
        void* kargs[] = {&a};
        hipError_t e = hipLaunchCooperativeKernel((const void*)nsa_fwd, dim3(grid), dim3(NTHREADS), kargs, LDS_BYTES, stream);
        if (e != hipSuccess) { fprintf(stderr, "cooperative launch failed: %s\n", hipGetErrorString(e)); break; }
    }
#else
    a.ph_lo = 0; a.ph_hi = 11;
    void* kargs[] = {&a};
    hipError_t e = hipLaunchCooperativeKernel((const void*)nsa_fwd, dim3(grid), dim3(NTHREADS), kargs, LDS_BYTES, stream);
    if (e != hipSuccess) fprintf(stderr, "cooperative launch failed: %s (grid %d)\n", hipGetErrorString(e), grid);
#endif
}
```

```cpp
#include <hip/hip_runtime.h>
#include <hip/hip_cooperative_groups.h>
#include <cstdio>
#include <cstdint>
namespace cg = cooperative_groups;

#ifndef MK_PER_PHASE
#define MK_PER_PHASE 0
#endif

#define LAS __attribute__((address_space(3)))
typedef unsigned short bf16_t;
typedef short bf16x8 __attribute__((ext_vector_type(8)));
typedef short bf16x4 __attribute__((ext_vector_type(4)));
typedef float f32x4 __attribute__((ext_vector_type(4)));
typedef unsigned u32x4 __attribute__((ext_vector_type(4)));
typedef unsigned u32x2 __attribute__((ext_vector_type(2)));

constexpr int M = 16384, D = 1024, FF = 2816, NP = 7168, IN_TOTAL = 6960;
constexpr int NWAVES = 8, NTHREADS = 512;
constexpr float EPS = 1e-6f;
constexpr float LOG2E = 1.4426950408889634f;
constexpr float SC = 0.125f * LOG2E;
constexpr int LDS_BYTES = 157696;

constexpr size_t MiB = 1u << 20;
constexpr size_t WS_SSQ = 0;
constexpr size_t WS_KC = 1 * MiB;
constexpr size_t WS_VCT = 1 * MiB + 256 * 1024;
constexpr size_t WS_WK2 = 1 * MiB + 512 * 1024;
constexpr size_t WS_WV2 = 1 * MiB + 544 * 1024;
constexpr size_t WS_WK1 = 2 * MiB;
constexpr size_t WS_WV1 = 3 * MiB;
constexpr size_t WS_W1A = 4 * MiB;
constexpr size_t WS_W1D = 15 * MiB;
constexpr size_t WS_KB = 4 * MiB;
constexpr size_t WS_WIN = 21 * MiB;
constexpr size_t WS_XB = 35 * MiB;
constexpr size_t WS_WNA = 35 * MiB, WS_WCO = 37 * MiB, WS_WO = 39 * MiB, WS_W2A = 41 * MiB, WS_W2D = 52 * MiB;
constexpr size_t WS_QO = 67 * MiB;
constexpr size_t WS_VT = 99 * MiB;
constexpr size_t WS_G = 107 * MiB;
constexpr size_t WS_CB = 111 * MiB, WS_CU = 143 * MiB, WS_GA = 175 * MiB, WS_GB = 207 * MiB;
constexpr size_t WS_HB = 111 * MiB;
constexpr size_t WS_CTL = 20 * MiB + 512 * 1024;
constexpr size_t WS_RS0 = WS_CTL + 8192, WS_RSA = WS_RS0 + 65536, WS_RSB = WS_RSA + 65536;
constexpr size_t WS_RSC = WS_RSB + 65536;
constexpr size_t WS_PCNT = WS_CTL + 4096;
constexpr size_t CTL_BYTES = 8192 + 4 * 65536;
static_assert(WS_CTL + CTL_BYTES <= WS_WIN && WS_CTL >= WS_W1D + (size_t)1024 * 2816 * 2, "control region sits in the free gap between W1D and WIN");
constexpr size_t WS_END = 239 * MiB;

typedef float f32x2_t __attribute__((ext_vector_type(2)));
typedef __bf16 bf16x2_t __attribute__((ext_vector_type(2)));
__device__ __forceinline__ unsigned cvt_pk_bf16(float lo, float hi) { f32x2_t v = {lo, hi}; bf16x2_t b = __builtin_convertvector(v, bf16x2_t); return __builtin_bit_cast(unsigned, b); }
__device__ __forceinline__ float bf2f(unsigned short b) { return __builtin_bit_cast(float, (unsigned)b << 16); }
__device__ __forceinline__ float bflo(unsigned w) { return __builtin_bit_cast(float, w << 16); }
__device__ __forceinline__ float bfhi(unsigned w) { return __builtin_bit_cast(float, w & 0xffff0000u); }
__device__ __forceinline__ float fexp2(float x) { return __builtin_amdgcn_exp2f(x); }
__device__ __forceinline__ float frcp(float x) { return __builtin_amdgcn_rcpf(x); }
__device__ __forceinline__ float sigmoidf_(float x) { return frcp(1.f + fexp2(-x * LOG2E)); }
__device__ __forceinline__ float wave_sum(float v) {
#pragma unroll
    for (int o = 1; o < 64; o <<= 1) v += __shfl_xor(v, o);
    return v;
}
__device__ __forceinline__ float rs_row(const float* ssq, int row) {
    const float* p = ssq + (size_t)row * 16;
    f32x4 a, b, c, d;
    asm volatile("global_load_dwordx4 %0, %4, off sc1\n\tglobal_load_dwordx4 %1, %4, off offset:16 sc1\n\tglobal_load_dwordx4 %2, %4, off offset:32 sc1\n\tglobal_load_dwordx4 %3, %4, off offset:48 sc1\n\ts_waitcnt vmcnt(0)"
                 : "=&v"(a), "=&v"(b), "=&v"(c), "=&v"(d) : "v"(p) : "memory");
    float s = ((a.x + a.y) + (a.z + a.w)) + ((b.x + b.y) + (b.z + b.w)) + ((c.x + c.y) + (c.z + c.w)) + ((d.x + d.y) + (d.z + d.w));
    return rsqrtf(s * (1.f / 1024.f) + EPS);
}

namespace pg8 {
constexpr int BM = 256, BK = 64, HALF = 128, HTB = HALF * BK * 2, NXCD = 8, WGM = 8;
__host__ __device__ __forceinline__ int lds_byte(int r, int c) { const int st = (r >> 4) * 2 + (c >> 5), rr = r & 15, cc = c & 31, ob = rr * 64 + cc * 2; return st * 1024 + (ob ^ (((ob >> 9) & 1) << 5)); }
__host__ __device__ __forceinline__ void stage_rc(int b, int& R, int& C) { const int st = b / 1024, sb = b % 1024, swz = sb ^ (((sb >> 9) & 1) << 5); R = (st >> 1) * 16 + swz / 64; C = (st & 1) * 32 + (swz % 64) / 2; }
__host__ __device__ __forceinline__ int perm32(int rho) { const int n = rho >> 4, i = rho & 15; return 8 * (i >> 2) + 4 * n + (i & 3); }
struct Unit { int pm, pn; };
struct Gemm { const bf16_t* A; const bf16_t* Bt; int M, N, K; };
struct StaticOrder {
    int nM, nN, nwg, G, c;
    __host__ __device__ void init(int M_, int N_, int G_, int c_) { nM = M_ / BM; nN = N_ / BM; nwg = nM * nN; G = G_; c = c_; }
    __host__ __device__ bool next(int i, Unit& u) const {
        const long L = (long)i * G + c; if (L >= nwg) return false;
        int wgid = (int)L; { const int q = nwg / NXCD, r = nwg % NXCD, xcd = wgid % NXCD, off = wgid / NXCD; wgid = (xcd < r ? xcd * (q + 1) : r * (q + 1) + (xcd - r) * q) + off; }
        const int nig = WGM * nN, gid = wgid / nig, fm = gid * WGM, gsz = (nM - fm) < WGM ? (nM - fm) : WGM;
        u.pm = fm + ((wgid % nig) % gsz); u.pn = (wgid % nig) / gsz; return true;
    }
};
template <class Epi>
__device__ __forceinline__ void gemm_phase(LAS unsigned char* lds, const Gemm g, const StaticOrder& S, const Epi& E) {
    const int tid = threadIdx.x, wid = __builtin_amdgcn_readfirstlane(tid >> 6), lane = tid & 63, wr = wid >> 2, wc = wid & 3, fr = lane & 15, fq = lane >> 4;
    const int K = g.K, nt = K / BK;
    unsigned voffA[2], voffB[2];
#pragma unroll
    for (int i = 0; i < 2; ++i) { int R, C; stage_rc(tid * 16 + i * 8192, R, C); const int Rb = (R & ~31) + perm32(R & 31);
        voffA[i] = (unsigned)(R * K + C) * 2u; voffB[i] = (unsigned)(Rb * K + C) * 2u; }
    const size_t kstep = (size_t)(BK * 2);
    const size_t hstep = (size_t)HALF * K * 2;
    const size_t tstep = 2 * hstep;
    const unsigned ldsw = (unsigned)wid * 1024u;
    const int aoff = lds_byte(wr * 64 + fr, fq * 8), boff = lds_byte(wc * 32 + fr, fq * 8);
#define PG8_SA(b, h) (((b) * 2 + (h)) * HTB)
#define PG8_SB(b, h) ((4 + (b) * 2 + (h)) * HTB)
#define PG8_STAGE(bufoff, gbase, voff) do { _Pragma("unroll") for (int _i = 0; _i < 2; ++_i) \
        __builtin_amdgcn_global_load_lds((const unsigned*)((const char*)(gbase) + (voff)[_i]), (LAS unsigned*)(lds + (bufoff) + ldsw + _i * 8192), 16, 0, 0); } while (0)
#define PG8_LDA(dst, b, h) do { _Pragma("unroll") for (int m = 0; m < 4; ++m) _Pragma("unroll") for (int k = 0; k < 2; ++k) dst[m][k] = *(const LAS bf16x8*)(lds + PG8_SA(b, h) + aoff + m * 2048 + k * 1024); } while (0)
#define PG8_LDB(dst, b, h) do { _Pragma("unroll") for (int n = 0; n < 2; ++n) _Pragma("unroll") for (int k = 0; k < 2; ++k) dst[n][k] = *(const LAS bf16x8*)(lds + PG8_SB(b, h) + boff + n * 2048 + k * 1024); } while (0)
#define PG8_MMA(ai, bj, At, Bt) do { __builtin_amdgcn_s_setprio(1); _Pragma("unroll") for (int m = 0; m < 4; ++m) _Pragma("unroll") for (int n = 0; n < 2; ++n) _Pragma("unroll") for (int k = 0; k < 2; ++k) \
        acc[ai][bj][m][n] = __builtin_amdgcn_mfma_f32_16x16x32_bf16(Bt[n][k], At[m][k], acc[ai][bj][m][n], 0, 0, 0); __builtin_amdgcn_s_setprio(0); } while (0)
#define PG8_WAIT_V(n) asm volatile("s_waitcnt vmcnt(" #n ")" ::: "memory")
#define PG8_WAIT_L(n) asm volatile("s_waitcnt lgkmcnt(" #n ")" ::: "memory")
#define PG8_BAR __builtin_amdgcn_s_barrier()
#define PG8_SCHED __builtin_amdgcn_sched_barrier(0)
    Unit cur, nxt; int ui = 0;
    if (!S.next(0, cur)) return;
    f32x4 acc[2][2][4][2];
#pragma unroll
    for (int a = 0; a < 2; ++a)
#pragma unroll
        for (int b = 0; b < 2; ++b)
#pragma unroll
            for (int m = 0; m < 4; ++m)
#pragma unroll
                for (int n = 0; n < 2; ++n) acc[a][b][m][n] = (f32x4){0.f, 0.f, 0.f, 0.f};
    bf16x8 At[4][2], B0[2][2], B1[2][2];
    const char* cA = (const char*)g.A + (size_t)cur.pm * tstep; const char* cB = (const char*)g.Bt + (size_t)cur.pn * tstep;
    PG8_STAGE(PG8_SB(0, 0), cB, voffB); PG8_STAGE(PG8_SB(0, 1), cB + hstep, voffB); PG8_STAGE(PG8_SA(0, 0), cA, voffA); PG8_STAGE(PG8_SA(0, 1), cA + hstep, voffA);
    if (wr == 1) PG8_BAR;
    PG8_WAIT_V(2); PG8_BAR;
    PG8_STAGE(PG8_SB(1, 0), cB + kstep, voffB); PG8_STAGE(PG8_SA(1, 0), cA + kstep, voffA); PG8_STAGE(PG8_SB(1, 1), cB + hstep + kstep, voffB);
    PG8_WAIT_V(6); PG8_BAR;
    for (;;) {
        const bool has_next = S.next(ui + 1, nxt);
        const char* nA = has_next ? (const char*)g.A + (size_t)nxt.pm * tstep : cA; const char* nB = has_next ? (const char*)g.Bt + (size_t)nxt.pn * tstep : cB;
        for (int t = 0; t < nt; t += 2) {
            const bool last = (t == nt - 2);
            const char* a1 = cA + (size_t)(t + 1) * kstep;
            const char* a2 = last ? nA : cA + (size_t)(t + 2) * kstep; const char* b2 = last ? nB : cB + (size_t)(t + 2) * kstep;
            const char* a3 = a2 + kstep; const char* b3 = b2 + kstep;
            PG8_LDB(B0, 0, 0); PG8_LDB(B1, 0, 1); PG8_SCHED; PG8_LDA(At, 0, 0); PG8_STAGE(PG8_SA(1, 1), a1 + hstep, voffA);
            PG8_WAIT_V(8); PG8_WAIT_L(0); PG8_BAR; PG8_MMA(0, 0, At, B0); PG8_MMA(0, 1, At, B1); PG8_BAR; PG8_SCHED;
            PG8_LDA(At, 0, 1); PG8_STAGE(PG8_SB(0, 0), b2, voffB); PG8_STAGE(PG8_SB(0, 1), b2 + hstep, voffB); PG8_STAGE(PG8_SA(0, 0), a2, voffA);
            PG8_WAIT_V(8); PG8_WAIT_L(0); PG8_BAR; PG8_MMA(1, 0, At, B0); PG8_MMA(1, 1, At, B1); PG8_BAR; PG8_SCHED;
            PG8_LDB(B0, 1, 0); PG8_LDB(B1, 1, 1); PG8_SCHED; PG8_LDA(At, 1, 0); PG8_STAGE(PG8_SA(0, 1), a2 + hstep, voffA);
            PG8_WAIT_V(8); PG8_WAIT_L(0); PG8_BAR; PG8_MMA(0, 0, At, B0); PG8_MMA(0, 1, At, B1); PG8_BAR; PG8_SCHED;
            PG8_LDA(At, 1, 1); PG8_STAGE(PG8_SB(1, 0), b3, voffB); PG8_STAGE(PG8_SB(1, 1), b3 + hstep, voffB); PG8_STAGE(PG8_SA(1, 0), a3, voffA);
            PG8_WAIT_V(8); PG8_WAIT_L(0); PG8_BAR; PG8_MMA(1, 0, At, B0); PG8_MMA(1, 1, At, B1); PG8_BAR; PG8_SCHED;
        }
        if (wr == 0) PG8_BAR;
        E(acc, cur, wr, wc, fr, fq);
        if (!has_next) break;
#pragma unroll
        for (int a = 0; a < 2; ++a)
#pragma unroll
            for (int b = 0; b < 2; ++b)
#pragma unroll
                for (int m = 0; m < 4; ++m)
#pragma unroll
                    for (int n = 0; n < 2; ++n) acc[a][b][m][n] = (f32x4){0.f, 0.f, 0.f, 0.f};
        cur = nxt; cA = nA; cB = nB; ++ui;
        if (wr == 1) PG8_BAR;
    }
    PG8_WAIT_V(0);
    PG8_BAR;
#undef PG8_SA
#undef PG8_SB
#undef PG8_STAGE
#undef PG8_LDA
#undef PG8_LDB
#undef PG8_MMA
#undef PG8_WAIT_V
#undef PG8_WAIT_L
#undef PG8_BAR
#undef PG8_SCHED
}

typedef f32x4 Acc[2][2][4][2];

struct EpiSwiglu {
    bf16_t* H; const float* rsum;
    __device__ __forceinline__ void operator()(const Acc& acc, const Unit& u, int wr, int wc, int fr, int fq) const {
        const int row0 = u.pm * BM + wr * 64 + fr, col0 = u.pn * 128 + wc * 32 + 8 * fq;
        float rsv[2][4];
#pragma unroll
        for (int ai = 0; ai < 2; ++ai)
#pragma unroll
            for (int m = 0; m < 4; ++m) rsv[ai][m] = rsum[row0 + ai * HALF + m * 16];
#pragma unroll
        for (int ai = 0; ai < 2; ++ai)
#pragma unroll
            for (int m = 0; m < 4; ++m) {
                const int row = row0 + ai * HALF + m * 16; const float rs = rsqrtf(rsv[ai][m] * (1.f / 1024.f) + EPS);
                float h[8];
#pragma unroll
                for (int n = 0; n < 2; ++n)
#pragma unroll
                    for (int i = 0; i < 4; ++i) { const float gt = acc[ai][0][m][n][i] * rs, up = acc[ai][1][m][n][i] * rs; h[n * 4 + i] = gt * sigmoidf_(gt) * up; }
                u32x4 w; w.x = cvt_pk_bf16(h[0], h[1]); w.y = cvt_pk_bf16(h[2], h[3]); w.z = cvt_pk_bf16(h[4], h[5]); w.w = cvt_pk_bf16(h[6], h[7]);
                *(u32x4*)(H + (size_t)row * FF + col0) = w;
            }
    }
};
struct EpiRes {
    const float* xin; float* xo; bf16_t* xb; float* rsum; float scale;
    __device__ __forceinline__ void operator()(const Acc& acc, const Unit& u, int wr, int wc, int fr, int fq) const {
        const int row0 = u.pm * BM + wr * 64 + fr, col0 = u.pn * BM + wc * 32 + 8 * fq;
#pragma unroll
        for (int ai = 0; ai < 2; ++ai)
#pragma unroll
            for (int m = 0; m < 4; ++m) {
                const int row = row0 + ai * HALF + m * 16; float ss = 0.f;
#pragma unroll
                for (int bj = 0; bj < 2; ++bj) {
                    const size_t off = (size_t)row * D + col0 + bj * HALF;
                    f32x4 x0 = *(const f32x4*)(xin + off), x1 = *(const f32x4*)(xin + off + 4);
                    x0 = x0 + acc[ai][bj][m][0] * scale; x1 = x1 + acc[ai][bj][m][1] * scale;
                    *(f32x4*)(xo + off) = x0; *(f32x4*)(xo + off + 4) = x1;
                    ss += (x0.x * x0.x + x0.y * x0.y) + (x0.z * x0.z + x0.w * x0.w) + (x1.x * x1.x + x1.y * x1.y) + (x1.z * x1.z + x1.w * x1.w);
                    if (xb) { u32x4 w; w.x = cvt_pk_bf16(x0.x, x0.y); w.y = cvt_pk_bf16(x0.z, x0.w); w.z = cvt_pk_bf16(x1.x, x1.y); w.w = cvt_pk_bf16(x1.z, x1.w); *(u32x4*)(xb + off) = w; }
                }
                ss += __shfl_xor(ss, 16); ss += __shfl_xor(ss, 32);
                if (fq == 0 && rsum) __hip_atomic_fetch_add(rsum + row, ss, __ATOMIC_RELAXED, __HIP_MEMORY_SCOPE_AGENT);
            }
    }
};
struct EpiFinal {
    float* xio; float* rsum; unsigned* pcnt; const float* gain;
    __device__ __forceinline__ void operator()(const Acc& acc, const Unit& u, int wr, int wc, int fr, int fq) const {
        const int row0 = u.pm * BM + wr * 64 + fr, col0 = u.pn * BM + wc * 32 + 8 * fq;
#pragma unroll
        for (int ai = 0; ai < 2; ++ai)
#pragma unroll
            for (int m = 0; m < 4; ++m) {
                const int row = row0 + ai * HALF + m * 16; float ss = 0.f;
#pragma unroll
                for (int bj = 0; bj < 2; ++bj) { const size_t off = (size_t)row * D + col0 + bj * HALF;
                    const f32x4 x0 = *(const f32x4*)(xio + off) + acc[ai][bj][m][0] * 0.5f, x1 = *(const f32x4*)(xio + off + 4) + acc[ai][bj][m][1] * 0.5f;
                    ss += (x0.x * x0.x + x0.y * x0.y) + (x0.z * x0.z + x0.w * x0.w) + (x1.x * x1.x + x1.y * x1.y) + (x1.z * x1.z + x1.w * x1.w); }
                ss += __shfl_xor(ss, 16); ss += __shfl_xor(ss, 32);
                if (fq == 0) __hip_atomic_fetch_add(rsum + row, ss, __ATOMIC_RELAXED, __HIP_MEMORY_SCOPE_AGENT);
            }
        asm volatile("s_waitcnt vmcnt(0) lgkmcnt(0)" ::: "memory");
        __syncthreads();
        if ((wr | wc | fr | fq) == 0) {
            unsigned* c = pcnt + 16 * u.pm;
            __hip_atomic_fetch_add(c, 1u, __ATOMIC_RELEASE, __HIP_MEMORY_SCOPE_AGENT);
            while (__hip_atomic_load(c, __ATOMIC_RELAXED, __HIP_MEMORY_SCOPE_AGENT) < 4u) __builtin_amdgcn_s_sleep(2);
        }
        __syncthreads();
#pragma unroll
        for (int ai = 0; ai < 2; ++ai)
#pragma unroll
            for (int m = 0; m < 4; ++m) {
                const int row = row0 + ai * HALF + m * 16;
                const float rs = rsqrtf(__hip_atomic_load(rsum + row, __ATOMIC_RELAXED, __HIP_MEMORY_SCOPE_AGENT) * (1.f / 1024.f) + EPS);
#pragma unroll
                for (int bj = 0; bj < 2; ++bj) { const size_t off = (size_t)row * D + col0 + bj * HALF;
                    const f32x4 g0 = *(const f32x4*)(gain + col0 + bj * HALF), g1 = *(const f32x4*)(gain + col0 + bj * HALF + 4);
                    const f32x4 x0 = (*(const f32x4*)(xio + off) + acc[ai][bj][m][0] * 0.5f) * rs * g0, x1 = (*(const f32x4*)(xio + off + 4) + acc[ai][bj][m][1] * 0.5f) * rs * g1;
                    *(f32x4*)(xio + off) = x0; *(f32x4*)(xio + off + 4) = x1; }
            }
    }
};
struct EpiWin {
    unsigned char* ws; const float* rsum;
    __device__ __forceinline__ void operator()(const Acc& acc, const Unit& u, int wr, int wc, int fr, int fq) const {
        const int row0 = u.pm * BM + wr * 64 + fr, cc0 = wc * 32 + 8 * fq;
        const int pn = u.pn;
        float rsv[2][4];
#pragma unroll
        for (int ai = 0; ai < 2; ++ai)
#pragma unroll
            for (int m = 0; m < 4; ++m) rsv[ai][m] = rsum[row0 + ai * HALF + m * 16];
#pragma unroll
        for (int ai = 0; ai < 2; ++ai)
#pragma unroll
            for (int m = 0; m < 4; ++m) {
                const int row = row0 + ai * HALF + m * 16; const float rs = rsqrtf(rsv[ai][m] * (1.f / 1024.f) + EPS);
                if (pn >= 12 && pn < 20) {
                    float v[8];
#pragma unroll
                    for (int n = 0; n < 2; ++n)
#pragma unroll
                        for (int i = 0; i < 4; ++i) v[n * 4 + i] = (acc[ai][0][m][n][i] * rs) * (acc[ai][1][m][n][i] * rs);
                    u32x4 w; w.x = cvt_pk_bf16(v[0], v[1]); w.y = cvt_pk_bf16(v[2], v[3]); w.z = cvt_pk_bf16(v[4], v[5]); w.w = cvt_pk_bf16(v[6], v[7]);
                    *(u32x4*)((bf16_t*)(ws + WS_CU) + (size_t)row * D + (pn - 12) * 128 + cc0) = w;
                    continue;
                }
#pragma unroll
                for (int bj = 0; bj < 2; ++bj) {
                    float v[8];
#pragma unroll
                    for (int n = 0; n < 2; ++n)
#pragma unroll
                        for (int i = 0; i < 4; ++i) v[n * 4 + i] = acc[ai][bj][m][n][i] * rs;
                    const int cc = bj * HALF + cc0;
                    if (pn == 7) {
                        if (cc < 48) { float* gp = (float*)(ws + WS_G) + (size_t)row * 48 + cc;
                            *(f32x4*)gp = (f32x4){sigmoidf_(v[0]), sigmoidf_(v[1]), sigmoidf_(v[2]), sigmoidf_(v[3])};
                            *(f32x4*)(gp + 4) = (f32x4){sigmoidf_(v[4]), sigmoidf_(v[5]), sigmoidf_(v[6]), sigmoidf_(v[7])}; }
                        continue;
                    }
                    if (pn == 6) {
                        bf16_t* vt = (bf16_t*)(ws + WS_VT) + ((size_t)(bj * 2 + (cc0 >> 6)) * 64 + (cc0 & 63)) * M + row;
#pragma unroll
                        for (int i = 0; i < 8; ++i) vt[(size_t)i * M] = (bf16_t)(cvt_pk_bf16(v[i], 0.f) & 0xffffu);
                        continue;
                    }
                    if (pn >= 20) {
#pragma unroll
                        for (int i = 0; i < 8; ++i) v[i] = sigmoidf_(v[i]);
                    }
                    u32x4 w; w.x = cvt_pk_bf16(v[0], v[1]); w.y = cvt_pk_bf16(v[2], v[3]); w.z = cvt_pk_bf16(v[4], v[5]); w.w = cvt_pk_bf16(v[6], v[7]);
                    bf16_t* dst;
                    if (pn < 4) dst = (bf16_t*)(ws + WS_QO) + (size_t)row * D + pn * BM + cc;
                    else if (pn < 6) dst = (bf16_t*)(ws + WS_KB) + (size_t)row * 512 + (pn - 4) * BM + cc;
                    else if (pn < 12) dst = (bf16_t*)(ws + WS_CB) + (size_t)row * D + (pn - 8) * BM + cc;
                    else if (pn < 24) dst = (bf16_t*)(ws + WS_GA) + (size_t)row * D + (pn - 20) * BM + cc;
                    else dst = (bf16_t*)(ws + WS_GB) + (size_t)row * D + (pn - 24) * BM + cc;
                    *(u32x4*)dst = w;
                }
            }
    }
};
template <int MODE> struct EpiMerge {
    bf16_t* T; const bf16_t* Sg;
    __device__ __forceinline__ void operator()(const Acc& acc, const Unit& u, int wr, int wc, int fr, int fq) const {
        const int row0 = u.pm * BM + wr * 64 + fr, col0 = u.pn * BM + wc * 32 + 8 * fq;
#pragma unroll
        for (int ai = 0; ai < 2; ++ai)
#pragma unroll
            for (int m = 0; m < 4; ++m) {
                const int row = row0 + ai * HALF + m * 16;
#pragma unroll
                for (int bj = 0; bj < 2; ++bj) {
                    const size_t off = (size_t)row * D + col0 + bj * HALF;
                    const u32x4 sg = *(const u32x4*)(Sg + off);
                    float v[8];
                    v[0] = bflo(sg.x) * acc[ai][bj][m][0][0]; v[1] = bfhi(sg.x) * acc[ai][bj][m][0][1]; v[2] = bflo(sg.y) * acc[ai][bj][m][0][2]; v[3] = bfhi(sg.y) * acc[ai][bj][m][0][3];
                    v[4] = bflo(sg.z) * acc[ai][bj][m][1][0]; v[5] = bfhi(sg.z) * acc[ai][bj][m][1][1]; v[6] = bflo(sg.w) * acc[ai][bj][m][1][2]; v[7] = bfhi(sg.w) * acc[ai][bj][m][1][3];
                    if (MODE == 1) { const u32x4 t = *(const u32x4*)(T + off);
                        v[0] += bflo(t.x); v[1] += bfhi(t.x); v[2] += bflo(t.y); v[3] += bfhi(t.y); v[4] += bflo(t.z); v[5] += bfhi(t.z); v[6] += bflo(t.w); v[7] += bfhi(t.w); }
                    u32x4 w; w.x = cvt_pk_bf16(v[0], v[1]); w.y = cvt_pk_bf16(v[2], v[3]); w.z = cvt_pk_bf16(v[4], v[5]); w.w = cvt_pk_bf16(v[6], v[7]);
                    *(u32x4*)(T + off) = w;
                }
            }
    }
};
}

__device__ __forceinline__ void tr_item(const float* W, int K, int N, int sc0, int nvalid, const float* gain, bf16_t* WT, int dr0, int k0, LAS float* scr, int lane) {
    const int nl = lane & 31;
    float tv[32];
#pragma unroll
    for (int i = 0; i < 32; ++i) { const int kk = 2 * i + (lane >> 5); tv[i] = (nl < nvalid) ? __builtin_nontemporal_load(W + (size_t)(k0 + kk) * N + sc0 + nl) : 0.f; }
    if (gain) {
#pragma unroll
        for (int i = 0; i < 32; ++i) tv[i] *= gain[k0 + 2 * i + (lane >> 5)];
    }
#pragma unroll
    for (int i = 0; i < 32; ++i) scr[(2 * i + (lane >> 5)) * 33 + nl] = tv[i];
    asm volatile("s_waitcnt lgkmcnt(0)" ::: "memory");
    const int c = lane & 7;
#pragma unroll
    for (int j = 0; j < 4; ++j) { const int n = (lane >> 3) + 8 * j; const LAS float* s = scr + (8 * c) * 33 + n;
        u32x4 o; o.x = cvt_pk_bf16(s[0 * 33], s[1 * 33]); o.y = cvt_pk_bf16(s[2 * 33], s[3 * 33]); o.z = cvt_pk_bf16(s[4 * 33], s[5 * 33]); o.w = cvt_pk_bf16(s[6 * 33], s[7 * 33]);
        *(u32x4*)(WT + (size_t)(dr0 + n) * K + k0 + 8 * c) = o; }
    asm volatile("s_waitcnt lgkmcnt(0)" ::: "memory");
}
__device__ __forceinline__ int win_src(int d0, int& nvalid) {
    nvalid = 32;
    if (d0 < 1152) return d0;
    if (d0 < 1280) return 1280 + (d0 - 1152);
    if (d0 < 1408) return 1536 + (d0 - 1280);
    if (d0 < 1536) return 1152 + (d0 - 1408);
    if (d0 < 1664) return 1408 + (d0 - 1536);
    if (d0 < 1792) return 1664 + (d0 - 1664);
    if (d0 < 2048) { const int o = d0 - 1792; nvalid = o < 48 ? (48 - o < 32 ? 48 - o : 32) : 0; return nvalid ? 1792 + o : 0; }
    if (d0 < 3072) return 1840 + (d0 - 2048);
    if (d0 < 5120) { const int o = d0 - 3072, tile = o >> 8, half = (o >> 7) & 1, i = o & 127; return (half ? 3888 : 2864) + tile * 128 + i; }
    if (d0 < 6144) return 4912 + (d0 - 5120);
    return 5936 + (d0 - 6144);
}

struct Args { const float* in[22]; float* out; unsigned char* ws; int ph_lo, ph_hi; };

__device__ __forceinline__ void conv_ffn_up_item(const float* wg, const float* wu, const float* gain, bf16_t* dst, int r, LAS float* scr, int lane) {
    const int kb = r / 176, nb = r % 176, d0 = nb * 32; const int tile = d0 >> 8, half = (d0 >> 7) & 1, i = d0 & 127;
    tr_item(half ? wu : wg, D, FF, tile * 128 + i, 32, gain, dst, d0, kb * 64, scr, lane);
}

__device__ __forceinline__ void compress_item(LAS unsigned char* lds, int item, const bf16_t* KB, const float* pe, const bf16_t* W1t, const bf16_t* W2t, bf16_t* KC, bf16_t* VCT, int kv) {
    const int tid = threadIdx.x, lane = tid & 63, w = __builtin_amdgcn_readfirstlane(tid >> 6), l15 = lane & 15, G = lane >> 4;
    const int rt = w >> 2, cgp = w & 3;
    constexpr int BS_OFF = 20480, BS_BYTES = 256 * 144, AS_OFF = BS_OFF + 2 * BS_BYTES, AS_BYTES = 32 * 144;
    f32x4 acc[4];
#pragma unroll
    for (int i = 0; i < 4; ++i) acc[i] = (f32x4){0.f, 0.f, 0.f, 0.f};
    const int ar = (tid >> 3) & 31, aseg = tid & 7;
    const int aR = item * 32 + ar; int ac = aR >> 1; const int agg = aR & 1; if (ac > 1022) ac = 1022;
    const bf16_t* asrc = KB + (size_t)(ac * 16) * 512 + (kv ? 384 : 0) + agg * 64 + aseg * 8;
    const bf16_t* bsrc = W1t + (size_t)(tid >> 3) * 2048 + (tid & 7) * 8;
    u32x4 bregX[4], aregX, bregY[4], aregY; f32x4 pe0X, pe1X, pe0Y, pe1Y;
#define CMP_LOAD(s_, breg, areg, pe0, pe1) do { _Pragma("unroll") for (int j = 0; j < 4; ++j) breg[j] = *(const u32x4*)(bsrc + (size_t)j * 64 * 2048 + (s_) * 64); \
        if (tid < 256) { areg = *(const u32x4*)(asrc + (size_t)(s_) * 512); pe0 = *(const f32x4*)(pe + (s_) * 64 + aseg * 8); pe1 = *(const f32x4*)(pe + (s_) * 64 + aseg * 8 + 4); } } while (0)
#define CMP_STORE(buf_, breg, areg, pe0, pe1) do { _Pragma("unroll") for (int j = 0; j < 4; ++j) *(LAS u32x4*)(lds + BS_OFF + (buf_) * BS_BYTES + ((tid >> 3) + 64 * j) * 144 + (tid & 7) * 16) = breg[j]; \
        if (tid < 256) { u32x4 aw; aw.x = cvt_pk_bf16(bflo(areg.x) + pe0.x, bfhi(areg.x) + pe0.y); aw.y = cvt_pk_bf16(bflo(areg.y) + pe0.z, bfhi(areg.y) + pe0.w); \
            aw.z = cvt_pk_bf16(bflo(areg.z) + pe1.x, bfhi(areg.z) + pe1.y); aw.w = cvt_pk_bf16(bflo(areg.w) + pe1.z, bfhi(areg.w) + pe1.w); \
            *(LAS u32x4*)(lds + AS_OFF + (buf_) * AS_BYTES + ar * 144 + aseg * 16) = aw; } } while (0)
#define CMP_COMPUTE(buf_) do { \
        const LAS unsigned char* Ab = lds + AS_OFF + (buf_) * AS_BYTES + (rt * 16 + l15) * 144 + G * 16; \
        const LAS unsigned char* Bb = lds + BS_OFF + (buf_) * BS_BYTES + (cgp * 64 + l15) * 144 + G * 16; \
        _Pragma("unroll") for (int kc = 0; kc < 2; ++kc) { const bf16x8 afr = *(const LAS bf16x8*)(Ab + kc * 64); \
            _Pragma("unroll") for (int nt = 0; nt < 4; ++nt) { const bf16x8 bfr = *(const LAS bf16x8*)(Bb + nt * 16 * 144 + kc * 64); \
                acc[nt] = __builtin_amdgcn_mfma_f32_16x16x32_bf16(afr, bfr, acc[nt], 0, 0, 0); } } } while (0)
    __syncthreads();
    CMP_LOAD(0, bregX, aregX, pe0X, pe1X); CMP_LOAD(1, bregY, aregY, pe0Y, pe1Y);
    CMP_STORE(0, bregX, aregX, pe0X, pe1X);
    __syncthreads();
    for (int st = 0; st < 32; st += 2) {
        if (st + 2 < 32) CMP_LOAD(st + 2, bregX, aregX, pe0X, pe1X);
        CMP_COMPUTE(0);
        CMP_STORE(1, bregY, aregY, pe0Y, pe1Y);
        __syncthreads();
        if (st + 3 < 32) CMP_LOAD(st + 3, bregY, aregY, pe0Y, pe1Y);
        CMP_COMPUTE(1);
        if (st + 2 < 32) CMP_STORE(0, bregX, aregX, pe0X, pe1X);
        __syncthreads();
    }
#undef CMP_COMPUTE
#undef CMP_LOAD
#undef CMP_STORE
    LAS bf16_t* HID = (LAS bf16_t*)lds;
    __syncthreads();
#pragma unroll
    for (int nt = 0; nt < 4; ++nt)
#pragma unroll
        for (int r = 0; r < 4; ++r) { const float x = acc[nt][r]; const float y = 0.7978845608028654f * (x + 0.044715f * x * x * x); const float gl = x * frcp(1.f + fexp2(-2.f * LOG2E * y));
            HID[(rt * 16 + G * 4 + r) * 264 + cgp * 64 + nt * 16 + l15] = (bf16_t)(cvt_pk_bf16(gl, 0.f) & 0xffffu); }
    __syncthreads();
    const int dt = w & 3;
    f32x4 o = (f32x4){0.f, 0.f, 0.f, 0.f};
#pragma unroll
    for (int kk = 0; kk < 8; ++kk) {
        const bf16x8 a = *(const LAS bf16x8*)(HID + (rt * 16 + l15) * 264 + kk * 32 + G * 8);
        const bf16x8 b = *(const bf16x8*)(W2t + (size_t)(dt * 16 + l15) * 256 + kk * 32 + G * 8);
        o = __builtin_amdgcn_mfma_f32_16x16x32_bf16(a, b, o, 0, 0, 0);
    }
#pragma unroll
    for (int r = 0; r < 4; ++r) { const int Ro = item * 32 + rt * 16 + G * 4 + r, co = Ro >> 1, go = Ro & 1, d = dt * 16 + l15;
        const bf16_t val = (co > 1022) ? (bf16_t)0 : (bf16_t)(cvt_pk_bf16(o[r], 0.f) & 0xffffu);
        if (kv == 0) KC[(size_t)(co * 2 + go) * 64 + d] = val; else VCT[(size_t)(go * 64 + d) * 1024 + co] = val; }
    __syncthreads();
}

constexpr int A_PS = 0, A_SEL = 65536, A_R0 = 67584, A_QS = 92160;
#define GLDS16(gp, lp) __builtin_amdgcn_global_load_lds((const unsigned*)(gp), (LAS unsigned*)(lp), 16, 0, 0)
#define VMWAIT(n) asm volatile("s_waitcnt vmcnt(" #n ")" ::: "memory")
#define RAWBAR() __builtin_amdgcn_s_barrier()
template <int IPC, int D> __device__ __forceinline__ void ring_wait(int rem) {
    const int o = (rem < D - 1 ? rem : D - 1) * IPC;
    if (o >= 4) VMWAIT(4); else if (o == 3) VMWAIT(3); else if (o == 2) VMWAIT(2); else if (o == 1) VMWAIT(1); else VMWAIT(0);
}
__device__ __forceinline__ int swz(int r, int seg) { return r * 128 + ((seg ^ ((r >> 1) & 7)) << 4); }
__device__ __forceinline__ void qk64(const LAS unsigned char* Kst, int l15, int G, const LAS unsigned char* Qw, int ct, f32x4 (&s)[4]) {
    const int qr = ct * 16 + l15;
    const bf16x8 q0 = *(const LAS bf16x8*)(Qw + swz(qr, G)), q1 = *(const LAS bf16x8*)(Qw + swz(qr, 4 + G));
#pragma unroll
    for (int kt = 0; kt < 4; ++kt) {
        const int kr = kt * 16 + l15;
        const bf16x8 a0 = *(const LAS bf16x8*)(Kst + swz(kr, G)), a1 = *(const LAS bf16x8*)(Kst + swz(kr, 4 + G));
        f32x4 z = (f32x4){0.f, 0.f, 0.f, 0.f};
        z = __builtin_amdgcn_mfma_f32_16x16x32_bf16(a0, q0, z, 0, 0, 0);
        z = __builtin_amdgcn_mfma_f32_16x16x32_bf16(a1, q1, z, 0, 0, 0);
        s[kt] = z;
    }
}
__device__ __forceinline__ void pv64(const LAS unsigned char* Vst, int l15, int G, const f32x4 (&p)[4], f32x4 (&o)[4]) {
    u32x4 w0, w1;
    w0.x = cvt_pk_bf16(p[0][0], p[0][1]); w0.y = cvt_pk_bf16(p[0][2], p[0][3]); w0.z = cvt_pk_bf16(p[1][0], p[1][1]); w0.w = cvt_pk_bf16(p[1][2], p[1][3]);
    w1.x = cvt_pk_bf16(p[2][0], p[2][1]); w1.y = cvt_pk_bf16(p[2][2], p[2][3]); w1.z = cvt_pk_bf16(p[3][0], p[3][1]); w1.w = cvt_pk_bf16(p[3][2], p[3][3]);
    const bf16x8 p0 = __builtin_bit_cast(bf16x8, w0), p1 = __builtin_bit_cast(bf16x8, w1);
    const int hb = (G & 1) * 8, sg = G >> 1;
#pragma unroll
    for (int dt = 0; dt < 4; ++dt) {
        const int vr = dt * 16 + l15;
        u32x4 a0, a1;
        { const u32x2 x = *(const LAS u32x2*)(Vst + swz(vr, sg) + hb), y = *(const LAS u32x2*)(Vst + swz(vr, 2 + sg) + hb); a0.x = x.x; a0.y = x.y; a0.z = y.x; a0.w = y.y; }
        { const u32x2 x = *(const LAS u32x2*)(Vst + swz(vr, 4 + sg) + hb), y = *(const LAS u32x2*)(Vst + swz(vr, 6 + sg) + hb); a1.x = x.x; a1.y = x.y; a1.z = y.x; a1.w = y.y; }
        o[dt] = __builtin_amdgcn_mfma_f32_16x16x32_bf16(__builtin_bit_cast(bf16x8, a0), p0, o[dt], 0, 0, 0);
        o[dt] = __builtin_amdgcn_mfma_f32_16x16x32_bf16(__builtin_bit_cast(bf16x8, a1), p1, o[dt], 0, 0, 0);
    }
}
__device__ __forceinline__ void v_load(const LAS unsigned char* Vst, int l15, int G, u32x4 (&vf)[4][2]) {
    const int hb = (G & 1) * 8, sg = G >> 1;
#pragma unroll
    for (int dt = 0; dt < 4; ++dt) {
        const int vr = dt * 16 + l15;
        { const u32x2 x = *(const LAS u32x2*)(Vst + swz(vr, sg) + hb), y = *(const LAS u32x2*)(Vst + swz(vr, 2 + sg) + hb); vf[dt][0].x = x.x; vf[dt][0].y = x.y; vf[dt][0].z = y.x; vf[dt][0].w = y.y; }
        { const u32x2 x = *(const LAS u32x2*)(Vst + swz(vr, 4 + sg) + hb), y = *(const LAS u32x2*)(Vst + swz(vr, 6 + sg) + hb); vf[dt][1].x = x.x; vf[dt][1].y = x.y; vf[dt][1].z = y.x; vf[dt][1].w = y.y; }
    }
}
__device__ __forceinline__ void pv_mma(const u32x4 (&vf)[4][2], const f32x4 (&p)[4], f32x4 (&o)[4]) {
    u32x4 w0, w1;
    w0.x = cvt_pk_bf16(p[0][0], p[0][1]); w0.y = cvt_pk_bf16(p[0][2], p[0][3]); w0.z = cvt_pk_bf16(p[1][0], p[1][1]); w0.w = cvt_pk_bf16(p[1][2], p[1][3]);
    w1.x = cvt_pk_bf16(p[2][0], p[2][1]); w1.y = cvt_pk_bf16(p[2][2], p[2][3]); w1.z = cvt_pk_bf16(p[3][0], p[3][1]); w1.w = cvt_pk_bf16(p[3][2], p[3][3]);
    const bf16x8 p0 = __builtin_bit_cast(bf16x8, w0), p1 = __builtin_bit_cast(bf16x8, w1);
#pragma unroll
    for (int dt = 0; dt < 4; ++dt) {
        o[dt] = __builtin_amdgcn_mfma_f32_16x16x32_bf16(__builtin_bit_cast(bf16x8, vf[dt][0]), p0, o[dt], 0, 0, 0);
        o[dt] = __builtin_amdgcn_mfma_f32_16x16x32_bf16(__builtin_bit_cast(bf16x8, vf[dt][1]), p1, o[dt], 0, 0, 0);
    }
}
template <bool MASK> __device__ __forceinline__ float tile_max(const f32x4 (&s)[4], int lo, int hi) {
    float mx = -1e30f;
#pragma unroll
    for (int kt = 0; kt < 4; ++kt)
#pragma unroll
        for (int r = 0; r < 4; ++r) { float v = s[kt][r]; if (MASK) { const int c = kt * 16 + r; v = (c >= lo && c <= hi) ? v : -1e30f; } mx = fmaxf(mx, v); }
    return mx;
}
template <bool MASK> __device__ __forceinline__ float tile_exp(const f32x4 (&s)[4], int lo, int hi, float negm, f32x4 (&p)[4]) {
    f32x4 acc = (f32x4){0.f, 0.f, 0.f, 0.f};
#pragma unroll
    for (int kt = 0; kt < 4; ++kt) {
        const f32x4 t = s[kt] * SC + negm; f32x4 e;
#pragma unroll
        for (int r = 0; r < 4; ++r) { float x = fexp2(t[r]); if (MASK) { const int c = kt * 16 + r; x = (c >= lo && c <= hi) ? x : 0.f; } e[r] = x; }
        p[kt] = e; acc = acc + e;
    }
    return (acc[0] + acc[1]) + (acc[2] + acc[3]);
}
template <bool MASK> __device__ __forceinline__ void stats_body(const f32x4 (&s)[4], int lo, int hi, float& m, float& l) {
    const float mn = fmaxf(m, tile_max<MASK>(s, lo, hi) * SC);
    f32x4 p[4]; const float sum = tile_exp<MASK>(s, lo, hi, -mn, p);
    l = l * fexp2(m - mn) + sum; m = mn;
}
__device__ __forceinline__ void swap32(float& a, float& b) { asm("s_nop 1\n\tv_permlane32_swap_b32 %0, %1\n\ts_nop 1" : "+v"(a), "+v"(b)); }
__device__ __forceinline__ void swap16(float& a, float& b) { asm("s_nop 1\n\tv_permlane16_swap_b32 %0, %1\n\ts_nop 1" : "+v"(a), "+v"(b)); }
__device__ __forceinline__ float xmax4(float v) {
    float a = v, b = v; swap32(a, b); v = fmaxf(a, b);
    a = v; b = v; swap16(a, b); return fmaxf(a, b);
}
__device__ __forceinline__ float xsum4(float v) {
    float a = v, b = v; swap32(a, b); v = a + b;
    a = v; b = v; swap16(a, b); return a + b;
}
#define DPPF(v, ctrl) __builtin_bit_cast(float, __builtin_amdgcn_update_dpp(0, __builtin_bit_cast(int, v), ctrl, 0xF, 0xF, true))
__device__ __forceinline__ float wave_max64(float v) {
    v = fmaxf(v, DPPF(v, 0xB1)); v = fmaxf(v, DPPF(v, 0x4E)); v = fmaxf(v, DPPF(v, 0x141)); v = fmaxf(v, DPPF(v, 0x128));
    return xmax4(v);
}
__device__ __forceinline__ float dpp_sum8(float v) {
    v += __builtin_bit_cast(float, __builtin_amdgcn_update_dpp(0, __builtin_bit_cast(int, v), 0xB1, 0xF, 0xF, true));
    v += __builtin_bit_cast(float, __builtin_amdgcn_update_dpp(0, __builtin_bit_cast(int, v), 0x4E, 0xF, 0xF, true));
    v += __builtin_bit_cast(float, __builtin_amdgcn_update_dpp(0, __builtin_bit_cast(int, v), 0x141, 0xF, 0xF, true));
    return v;
}

__device__ __forceinline__ void attn_unit(LAS unsigned char* lds, const int g, const int cur, const bf16_t* KC, const bf16_t* VCT, const bf16_t* KB, const bf16_t* VT, const bf16_t* Q, bf16_t* OUT, const float* GS) {
    const int tid = threadIdx.x, lane = tid & 63, w = __builtin_amdgcn_readfirstlane(tid >> 6), l15 = lane & 15, G = lane >> 4;
    const int t0 = cur * 64, tq0 = t0 + 8 * w, qsub = l15 >> 3, h = l15 & 7;
    LAS float* PS = (LAS float*)(lds + A_PS); LAS unsigned* SEL = (LAS unsigned*)(lds + A_SEL);
    LAS float* STASH = (LAS float*)(lds + A_R0);
    LAS unsigned char* QW = lds + A_QS + w * 8192;
    const int srow = tid >> 3, sseg = (tid & 7) ^ ((srow >> 1) & 7);
    const unsigned wofs = (unsigned)w * 1024u;
#pragma unroll
    for (int i = 0; i < 8; ++i) { const int pc = i * 64 + lane, r = pc >> 3, seg = pc & 7;
        const u32x4 v = *(const u32x4*)(Q + (size_t)(tq0 + (r >> 3)) * D + (8 * g + (r & 7)) * 64 + seg * 8);
        *(LAS u32x4*)(QW + swz(r, seg)) = v; }
    const int nch = (((t0 + 32) >> 4) >> 6) + 1;
    const bf16_t* kc_src = KC + (size_t)g * 64 + (size_t)srow * 128 + sseg * 8;
    const bf16_t* vc_src = VCT + (size_t)(g * 64 + srow) * 1024 + sseg * 8;
    const bf16_t* ks_src = KB + (size_t)srow * 512 + 128 + g * 64 + sseg * 8;
    const bf16_t* vs_src = VT + (size_t)((0 * 2 + g) * 64 + srow) * M + sseg * 8;
    const bf16_t* kw_src = KB + (size_t)srow * 512 + 256 + g * 64 + sseg * 8;
    const bf16_t* vw_src = VT + (size_t)((1 * 2 + g) * 64 + srow) * M + sseg * 8;
    const int cmax_lo = tq0 >= 31 ? ((tq0 - 31) >> 4) : -1, cmax_hi = (tq0 + 7) >= 31 ? ((tq0 + 7 - 31) >> 4) : -1;
    asm volatile("s_waitcnt vmcnt(0) lgkmcnt(0)" ::: "memory");
    float mc[4], lc[4];
#pragma unroll
    for (int ct = 0; ct < 4; ++ct) { mc[ct] = -1e30f; lc[ct] = 0.f; }
    {
        LAS unsigned char* R0 = lds + A_R0;
        for (int j = 0; j < 2 && j < nch; ++j) GLDS16(kc_src + (size_t)j * 8192, R0 + j * 8192 + wofs);
        for (int ch = 0; ch < nch; ++ch) {
            ring_wait<1, 2>(nch - 1 - ch); RAWBAR();
            if (ch + 2 < nch) GLDS16(kc_src + (size_t)(ch + 2) * 8192, R0 + ((ch + 2) % 3) * 8192 + wofs);
            const LAS unsigned char* KST = R0 + (ch % 3) * 8192;
            if (ch * 64 > cmax_hi) continue;
            const bool full = (ch * 64 + 63 <= cmax_lo);
#pragma unroll
            for (int ct = 0; ct < 4; ++ct) {
                if ((ct & 1) == 0) __builtin_amdgcn_sched_barrier(0);
                f32x4 s[4]; qk64(KST, l15, G, QW, ct, s);
                if (full) stats_body<false>(s, 0, 0, mc[ct], lc[ct]);
                else { const int tcol = tq0 + 2 * ct + qsub; const int cmax = tcol >= 31 ? ((tcol - 31) >> 4) : -1;
                       stats_body<true>(s, 0, cmax - (ch * 64 + 4 * G), mc[ct], lc[ct]); }
            }
        }
        RAWBAR();
    }
#pragma unroll
    for (int ct = 0; ct < 4; ++ct) {
        const float m = xmax4(mc[ct]);
        const float l = xsum4(lc[ct] * fexp2(mc[ct] - m));
        mc[ct] = m; lc[ct] = l;
    }
    {
        LAS unsigned char* R0 = lds + A_R0;
        float carry[4] = {0.f, 0.f, 0.f, 0.f};
        float negm[4];
#pragma unroll
        for (int ct = 0; ct < 4; ++ct) negm[ct] = lc[ct] > 0.f ? __builtin_amdgcn_logf(1.f / lc[ct]) - mc[ct] : -1e30f;
        for (int j = 0; j < 2 && j < nch; ++j) GLDS16(kc_src + (size_t)j * 8192, R0 + j * 8192 + wofs);
        for (int ch = 0; ch < nch; ++ch) {
            ring_wait<1, 2>(nch - 1 - ch); RAWBAR();
            if (ch + 2 < nch) GLDS16(kc_src + (size_t)(ch + 2) * 8192, R0 + ((ch + 2) % 3) * 8192 + wofs);
            const LAS unsigned char* KST = R0 + (ch % 3) * 8192;
            const bool none = (ch * 64 > cmax_hi), full = (ch * 64 + 63 <= cmax_lo);
#pragma unroll
            for (int ct = 0; ct < 4; ++ct) {
                if ((ct & 1) == 0) __builtin_amdgcn_sched_barrier(0);
                f32x4 p[4];
                if (none) {
#pragma unroll
                    for (int kt = 0; kt < 4; ++kt) p[kt] = (f32x4){0.f, 0.f, 0.f, 0.f};
                } else {
                    f32x4 s[4]; qk64(KST, l15, G, QW, ct, s);
                    if (full) tile_exp<false>(s, 0, 0, negm[ct], p);
                    else { const int tcol = tq0 + 2 * ct + qsub; const int cmax = tcol >= 31 ? ((tcol - 31) >> 4) : -1; tile_exp<true>(s, 0, cmax - (ch * 64 + 4 * G), negm[ct], p); }
                }
                float prev = carry[ct];
#pragma unroll
                for (int kt = 0; kt < 4; ++kt) {
                    const float gsum = dpp_sum8((p[kt][0] + p[kt][1]) + (p[kt][2] + p[kt][3])), last = dpp_sum8(p[kt][3]);
                    const float send = (G == 3) ? prev : last;
                    const float recv = __shfl(send, (lane + 48) & 63);
                    const int n = ch * 16 + kt * 4 + G;
                    if (h == 0) PS[(8 * w + 2 * ct + qsub) * 256 + n] = gsum + recv;
                    prev = last;
                }
                carry[ct] = prev;
            }
        }
    }
    __syncthreads();
    {
        const int ksel = cur + 1 < 16 ? cur + 1 : 16;
        unsigned act0 = 0, act1 = 0, act2 = 0, act3 = 0;
        for (int qi = 0; qi < 8; ++qi) {
            const int q = 8 * w + qi;
            float v0, v1, v2, v3;
            { const int n0 = lane, n1 = lane + 64, n2 = lane + 128, n3 = lane + 192;
              v0 = n0 <= cur ? PS[q * 256 + n0] : -2.f; v1 = n1 <= cur ? PS[q * 256 + n1] : -2.f; v2 = n2 <= cur ? PS[q * 256 + n2] : -2.f; v3 = n3 <= cur ? PS[q * 256 + n3] : -2.f;
              if (n0 == 0 || n0 == cur || n0 == cur - 1) v0 = 1e9f;
              if (n1 == cur || n1 == cur - 1) v1 = 1e9f;
              if (n2 == cur || n2 == cur - 1) v2 = 1e9f;
              if (n3 == cur || n3 == cur - 1) v3 = 1e9f; }
            unsigned taken = 0;
            for (int it = 0; it < ksel; ++it) {
                const float lm = fmaxf(fmaxf(v0, v1), fmaxf(v2, v3));
                const float wm = wave_max64(lm);
                const unsigned long long bal = __ballot(lm == wm);
                const int first = __ffsll((long long)bal) - 1;
                if (lane == first) {
                    if (v0 == wm) { v0 = -3.f; taken |= 1u; }
                    else if (v1 == wm) { v1 = -3.f; taken |= 2u; }
                    else if (v2 == wm) { v2 = -3.f; taken |= 4u; }
                    else { v3 = -3.f; taken |= 8u; }
                }
            }
            act0 |= ((taken >> 0) & 1u) << qi; act1 |= ((taken >> 1) & 1u) << qi; act2 |= ((taken >> 2) & 1u) << qi; act3 |= ((taken >> 3) & 1u) << qi;
        }
        LAS unsigned char* ACT = (LAS unsigned char*)SEL + w * 256;
        ACT[lane] = (unsigned char)act0; ACT[lane + 64] = (unsigned char)act1; ACT[lane + 128] = (unsigned char)act2; ACT[lane + 192] = (unsigned char)act3;
    }
#pragma unroll
    for (int ct = 0; ct < 4; ++ct) { STASH[(ct * 2 + 0) * 512 + tid] = mc[ct]; STASH[(ct * 2 + 1) * 512 + tid] = lc[ct]; }
    __syncthreads();
    LAS unsigned char* RG = lds + A_PS;
    f32x4 O[4][4];
#pragma unroll
    for (int ct = 0; ct < 4; ++ct)
#pragma unroll
        for (int dt = 0; dt < 4; ++dt) O[ct][dt] = (f32x4){0.f, 0.f, 0.f, 0.f};
    {
        float ms[4], ls[4];
#pragma unroll
        for (int ct = 0; ct < 4; ++ct) { ms[ct] = -1e30f; ls[ct] = 0.f; }
        const int nb = cur + 1;
#define SLC_ISSUE(nn) do { GLDS16(ks_src + (size_t)(nn) * 64 * 512, RG + ((nn) & 3) * 16384 + wofs); GLDS16(vs_src + (size_t)(nn) * 64, RG + ((nn) & 3) * 16384 + 8192 + wofs); } while (0)
        SLC_ISSUE(0); if (nb > 1) SLC_ISSUE(1);
        const LAS unsigned char* ACTW = (const LAS unsigned char*)SEL + w * 256;
        for (int n2 = 0; n2 < nb; n2 += 2) {
            const unsigned act2 = (unsigned)__builtin_amdgcn_readfirstlane((int)*(const LAS unsigned short*)(ACTW + n2));
            VMWAIT(0); RAWBAR();
            if (n2 + 2 < nb) SLC_ISSUE(n2 + 2);
            if (n2 + 3 < nb) SLC_ISSUE(n2 + 3);
          for (int n = n2; n < n2 + 2 && n < nb; ++n) {
            const unsigned actn = (act2 >> (8 * (n - n2))) & 0xffu;
            const LAS unsigned char* KST = RG + (n & 3) * 16384; const LAS unsigned char* VST = KST + 8192;
#pragma unroll
            for (int ct = 0; ct < 4; ++ct) {
                __builtin_amdgcn_sched_barrier(0);
                const unsigned bA = (actn >> (2 * ct)) & 1u, bB = (actn >> (2 * ct + 1)) & 1u;
                if (!(bA | bB)) continue;
                f32x4 s[4]; qk64(KST, l15, G, QW, ct, s);
                u32x4 vf[4][2]; v_load(VST, l15, G, vf);
                f32x4 p[4]; float mx, sum;
                const bool posmask = (n >= cur);
                const bool colsel = qsub ? (bB != 0) : (bA != 0);
                int hi = 0;
                if (!posmask) { mx = tile_max<false>(s, 0, 0); mx = colsel ? mx : -1e30f; }
                else { const int tcol = tq0 + 2 * ct + qsub; hi = colsel ? tcol - (64 * n + 4 * G) : -1; mx = tile_max<true>(s, 0, hi); }
                if (__any((ms[ct] < -1e29f) | (mx * SC > ms[ct] + 60.f))) {
                    const float mn = fmaxf(ms[ct], xmax4(mx) * SC), alpha = fexp2(ms[ct] - mn); ms[ct] = mn; ls[ct] *= alpha;
#pragma unroll
                    for (int dt = 0; dt < 4; ++dt) O[ct][dt] = O[ct][dt] * alpha;
                }
                if (!posmask) sum = tile_exp<false>(s, 0, 0, colsel ? -ms[ct] : -1e30f, p);
                else sum = tile_exp<true>(s, 0, hi, -ms[ct], p);
                ls[ct] += sum;
                pv_mma(vf, p, O[ct]);
                if (__any(mx * SC > ms[ct] + 8.f)) {
                    const float mxs = xmax4(mx) * SC;
                    {
                        const float mn = fmaxf(ms[ct], mxs), alpha = fexp2(ms[ct] - mn); ms[ct] = mn; ls[ct] *= alpha;
#pragma unroll
                        for (int dt = 0; dt < 4; ++dt) O[ct][dt] = O[ct][dt] * alpha;
                    }
                }
            }
          }
        }
#undef SLC_ISSUE
        RAWBAR();
#pragma unroll
        for (int ct = 0; ct < 4; ++ct) {
            const float l = xsum4(ls[ct]);
            const int tcol = tq0 + 2 * ct + qsub;
            const float gate = GS[(size_t)tcol * 48 + (8 * g + h) * 3 + 1];
            const float sc = l > 0.f ? gate / l : 0.f;
#pragma unroll
            for (int dt = 0; dt < 4; ++dt) O[ct][dt] = O[ct][dt] * sc;
        }
    }
    {
        float negm[4];
#pragma unroll
        for (int ct = 0; ct < 4; ++ct) { mc[ct] = STASH[(ct * 2 + 0) * 512 + tid]; lc[ct] = STASH[(ct * 2 + 1) * 512 + tid]; }
#pragma unroll
        for (int ct = 0; ct < 4; ++ct) { const int tcol = tq0 + 2 * ct + qsub; const float gt = GS[(size_t)tcol * 48 + (8 * g + h) * 3 + 0];
            negm[ct] = lc[ct] > 0.f ? __builtin_amdgcn_logf(gt / lc[ct]) - mc[ct] : -1e30f; }
        asm volatile("s_waitcnt vmcnt(0)" ::: "memory");
        for (int j = 0; j < 3 && j < nch; ++j) { GLDS16(kc_src + (size_t)j * 8192, RG + j * 16384 + wofs); GLDS16(vc_src + (size_t)j * 64, RG + j * 16384 + 8192 + wofs); }
        for (int ch = 0; ch < nch; ++ch) {
            ring_wait<2, 3>(nch - 1 - ch); RAWBAR();
            if (ch + 3 < nch) { GLDS16(kc_src + (size_t)(ch + 3) * 8192, RG + ((ch + 3) & 3) * 16384 + wofs); GLDS16(vc_src + (size_t)(ch + 3) * 64, RG + ((ch + 3) & 3) * 16384 + 8192 + wofs); }
            const LAS unsigned char* KST = RG + (ch & 3) * 16384; const LAS unsigned char* VST = KST + 8192;
            if (ch * 64 > cmax_hi) continue;
            const bool full = (ch * 64 + 63 <= cmax_lo);
#pragma unroll
            for (int ct = 0; ct < 4; ++ct) {
                if ((ct & 1) == 0) __builtin_amdgcn_sched_barrier(0);
                f32x4 s[4]; qk64(KST, l15, G, QW, ct, s);
                f32x4 p[4];
                if (full) tile_exp<false>(s, 0, 0, negm[ct], p);
                else { const int tcol = tq0 + 2 * ct + qsub; const int cmax = tcol >= 31 ? ((tcol - 31) >> 4) : -1; tile_exp<true>(s, 0, cmax - (ch * 64 + 4 * G), negm[ct], p); }
                pv64(VST, l15, G, p, O[ct]);
            }
        }
        RAWBAR();
    }
    {
        const int i0 = cur >= 8 ? 0 : 8 - cur, nw = 9 - i0, tkb = t0 - 512 + 64 * i0;
        float mw[4], lw[4];
#pragma unroll
        for (int ct = 0; ct < 4; ++ct) { mw[ct] = -1e30f; lw[ct] = 0.f; }
        for (int j = 0; j < 3 && j < nw; ++j) GLDS16(kw_src + (size_t)(tkb + 64 * j) * 512, RG + j * 16384 + wofs);
        for (int i = 0; i < nw; ++i) {
            ring_wait<1, 3>(nw - 1 - i); RAWBAR();
            if (i + 3 < nw) GLDS16(kw_src + (size_t)(tkb + 64 * (i + 3)) * 512, RG + ((i + 3) & 3) * 16384 + wofs);
            const LAS unsigned char* KST = RG + (i & 3) * 16384; const int tk0 = tkb + 64 * i;
            if (tk0 > tq0 + 7 || tk0 + 63 <= tq0 - 512) continue;
            const bool full = (tk0 + 63 <= tq0) && (tk0 > tq0 + 7 - 512);
#pragma unroll
            for (int ct = 0; ct < 4; ++ct) {
                if ((ct & 1) == 0) __builtin_amdgcn_sched_barrier(0);
                f32x4 s[4]; qk64(KST, l15, G, QW, ct, s);
                if (full) stats_body<false>(s, 0, 0, mw[ct], lw[ct]);
                else { const int tcol = tq0 + 2 * ct + qsub, b0 = tk0 + 4 * G; stats_body<true>(s, tcol - 511 - b0, tcol - b0, mw[ct], lw[ct]); }
            }
        }
        RAWBAR();
        float negm[4];
#pragma unroll
        for (int ct = 0; ct < 4; ++ct) {
            const float m = xmax4(mw[ct]);
            const float l = xsum4(lw[ct] * fexp2(mw[ct] - m));
            const int tcol = tq0 + 2 * ct + qsub;
            const float gt = GS[(size_t)tcol * 48 + (8 * g + h) * 3 + 2];
            negm[ct] = l > 0.f ? __builtin_amdgcn_logf(gt / l) - m : -1e30f;
        }
        asm volatile("s_waitcnt vmcnt(0)" ::: "memory");
        for (int j = 0; j < 3 && j < nw; ++j) { GLDS16(kw_src + (size_t)(tkb + 64 * j) * 512, RG + j * 16384 + wofs); GLDS16(vw_src + (size_t)(tkb + 64 * j), RG + j * 16384 + 8192 + wofs); }
        for (int i = 0; i < nw; ++i) {
            ring_wait<2, 3>(nw - 1 - i); RAWBAR();
            if (i + 3 < nw) { GLDS16(kw_src + (size_t)(tkb + 64 * (i + 3)) * 512, RG + ((i + 3) & 3) * 16384 + wofs); GLDS16(vw_src + (size_t)(tkb + 64 * (i + 3)), RG + ((i + 3) & 3) * 16384 + 8192 + wofs); }
            const LAS unsigned char* KST = RG + (i & 3) * 16384; const LAS unsigned char* VST = KST + 8192; const int tk0 = tkb + 64 * i;
            if (tk0 > tq0 + 7 || tk0 + 63 <= tq0 - 512) continue;
            const bool full = (tk0 + 63 <= tq0) && (tk0 > tq0 + 7 - 512);
#pragma unroll
            for (int ct = 0; ct < 4; ++ct) {
                if ((ct & 1) == 0) __builtin_amdgcn_sched_barrier(0);
                f32x4 s[4]; qk64(KST, l15, G, QW, ct, s);
                f32x4 p[4];
                if (full) tile_exp<false>(s, 0, 0, negm[ct], p);
                else { const int tcol = tq0 + 2 * ct + qsub, b0 = tk0 + 4 * G; tile_exp<true>(s, tcol - 511 - b0, tcol - b0, negm[ct], p); }
                pv64(VST, l15, G, p, O[ct]);
            }
        }
    }
#pragma unroll
    for (int ct = 0; ct < 4; ++ct) {
        bf16_t* op = OUT + (size_t)(tq0 + 2 * ct + qsub) * D + (8 * g + h) * 64 + 4 * G;
#pragma unroll
        for (int dt = 0; dt < 4; ++dt) { u32x2 wv; wv.x = cvt_pk_bf16(O[ct][dt][0], O[ct][dt][1]); wv.y = cvt_pk_bf16(O[ct][dt][2], O[ct][dt][3]); *(u32x2*)(op + dt * 16) = wv; }
    }
    asm volatile("s_waitcnt vmcnt(0) lgkmcnt(0)" ::: "memory");
    __syncthreads();
}

__global__ void __launch_bounds__(NTHREADS, 2) nsa_fwd(Args args) {
    extern __shared__ __attribute__((aligned(16))) unsigned char lds_raw[];
    LAS unsigned char* lds = (LAS unsigned char*)lds_raw;
    cg::grid_group grid = cg::this_grid();
    const int tid = threadIdx.x, lane = tid & 63, wave = __builtin_amdgcn_readfirstlane(tid >> 6);
    const int GSZ = gridDim.x, bid = blockIdx.x;
    const int gw = bid * NWAVES + wave, NGW = GSZ * NWAVES;
    unsigned char* ws = args.ws;
    const float* x = args.in[0];
    float* out = args.out;
    float* SSQ = (float*)(ws + WS_SSQ);
    const int lo = args.ph_lo, hi = args.ph_hi;
#ifndef PH_MASK
#define PH_MASK 0x7ff
#endif
#define IN(k) (((PH_MASK >> (k)) & 1) && lo <= (k) && (k) < hi)
#define SEAM(k) do { if (IN(k) && IN((k) + 1)) { \
        asm volatile("s_waitcnt vmcnt(0) lgkmcnt(0)" ::: "memory");        \
        __syncthreads(); \
        if (tid == 0) { \
            unsigned* ctr = (unsigned*)(ws + WS_CTL) + 64 * (k); \
            __builtin_amdgcn_fence(__ATOMIC_RELEASE, "agent"); asm volatile("s_waitcnt vmcnt(0)" ::: "memory");        \
            __hip_atomic_fetch_add(ctr, 1u, __ATOMIC_RELAXED, __HIP_MEMORY_SCOPE_AGENT); \
            while (__hip_atomic_load(ctr, __ATOMIC_RELAXED, __HIP_MEMORY_SCOPE_AGENT) < (unsigned)GSZ) __builtin_amdgcn_s_sleep(2); \
            __builtin_amdgcn_fence(__ATOMIC_ACQUIRE, "agent"); asm volatile("s_waitcnt vmcnt(0)" ::: "memory");        \
        } \
        __syncthreads(); } } while (0)

    grid.sync();
    if (IN(0)) {
        LAS float* scr = (LAS float*)(lds + wave * 16384);
        constexpr int I_UP = 16 * 176, I_DN = 44 * 32, I_WIN = 16 * 224, I_C1 = 32 * 8, I_C2 = 4 * 2;
        constexpr int NIT = I_UP + I_DN + I_WIN + 2 * I_C1 + 2 * I_C2;
        for (int it = gw; it < NIT; it += NGW) {
            int r = it;
            if (r < I_UP) { conv_ffn_up_item(args.in[2], args.in[3], args.in[1], (bf16_t*)(ws + WS_W1A), r, scr, lane); continue; } r -= I_UP;
            if (r < I_DN) { const int kb = r / 32, nb = r % 32; tr_item(args.in[4], FF, D, nb * 32, 32, nullptr, (bf16_t*)(ws + WS_W1D), nb * 32, kb * 64, scr, lane); continue; } r -= I_DN;
            if (r < I_WIN) { const int kb = r / 224, nb = r % 224; int nv; const int sc = win_src(nb * 32, nv); tr_item(args.in[6], D, IN_TOTAL, sc, nv, args.in[5], (bf16_t*)(ws + WS_WIN), nb * 32, kb * 64, scr, lane); continue; } r -= I_WIN;
            if (r < I_C1) { const int kb = r / 8, nb = r % 8; tr_item(args.in[9], 2048, 256, nb * 32, 32, nullptr, (bf16_t*)(ws + WS_WK1), nb * 32, kb * 64, scr, lane); continue; } r -= I_C1;
            if (r < I_C1) { const int kb = r / 8, nb = r % 8; tr_item(args.in[11], 2048, 256, nb * 32, 32, nullptr, (bf16_t*)(ws + WS_WV1), nb * 32, kb * 64, scr, lane); continue; } r -= I_C1;
            if (r < I_C2) { const int kb = r / 2, nb = r % 2; tr_item(args.in[10], 256, 64, nb * 32, 32, nullptr, (bf16_t*)(ws + WS_WK2), nb * 32, kb * 64, scr, lane); continue; } r -= I_C2;
            { const int kb = r / 2, nb = r % 2; tr_item(args.in[12], 256, 64, nb * 32, 32, nullptr, (bf16_t*)(ws + WS_WV2), nb * 32, kb * 64, scr, lane); }
        }
        bf16_t* XB = (bf16_t*)(ws + WS_XB);
        for (int m = gw; m < M; m += 2 * NGW) {
            const int m2 = m + NGW;
            const f32x4* xr = (const f32x4*)(x + (size_t)m * D) + lane; const f32x4* xr2 = (const f32x4*)(x + (size_t)(m2 < M ? m2 : m) * D) + lane;
            f32x4 va[4], vb[4];
#pragma unroll
            for (int j = 0; j < 4; ++j) { va[j] = __builtin_nontemporal_load(xr + 64 * j); vb[j] = __builtin_nontemporal_load(xr2 + 64 * j); }
            float s = 0.f, s2 = 0.f;
            unsigned long long* o8 = (unsigned long long*)(XB + (size_t)m * D) + lane; unsigned long long* o82 = (unsigned long long*)(XB + (size_t)(m2 < M ? m2 : m) * D) + lane;
#pragma unroll
            for (int j = 0; j < 4; ++j) { const f32x4 v = va[j]; s += (v.x * v.x + v.y * v.y) + (v.z * v.z + v.w * v.w);
                o8[64 * j] = (unsigned long long)cvt_pk_bf16(v.x, v.y) | ((unsigned long long)cvt_pk_bf16(v.z, v.w) << 32); }
            s = wave_sum(s);
            if (lane == 0) ((float*)(ws + WS_RS0))[m] = s;
            if (m2 < M) {
#pragma unroll
                for (int j = 0; j < 4; ++j) { const f32x4 v = vb[j]; s2 += (v.x * v.x + v.y * v.y) + (v.z * v.z + v.w * v.w);
                    o82[64 * j] = (unsigned long long)cvt_pk_bf16(v.x, v.y) | ((unsigned long long)cvt_pk_bf16(v.z, v.w) << 32); }
                s2 = wave_sum(s2);
                if (lane == 0) ((float*)(ws + WS_RS0))[m2] = s2;
            }
        }
    }
    SEAM(0);
    if (IN(1)) {
        pg8::Gemm g{(const bf16_t*)(ws + WS_XB), (const bf16_t*)(ws + WS_W1A), M, 2 * FF, D}; pg8::StaticOrder S; S.init(M, 2 * FF, GSZ, bid);
        pg8::EpiSwiglu E{(bf16_t*)(ws + WS_HB), (const float*)(ws + WS_RS0)};
        pg8::gemm_phase(lds, g, S, E);
    }
    SEAM(1);
    if (IN(2)) {
        pg8::Gemm g{(const bf16_t*)(ws + WS_HB), (const bf16_t*)(ws + WS_W1D), M, D, FF}; pg8::StaticOrder S; S.init(M, D, GSZ, bid);
        pg8::EpiRes E{x, out, (bf16_t*)(ws + WS_XB), (float*)(ws + WS_RSA), 0.5f};
        pg8::gemm_phase(lds, g, S, E);
    }
    SEAM(2);
    if (IN(3)) {
        pg8::Gemm g{(const bf16_t*)(ws + WS_XB), (const bf16_t*)(ws + WS_WIN), M, NP, D}; pg8::StaticOrder S; S.init(M, NP, GSZ, bid);
        pg8::EpiWin E{ws, (const float*)(ws + WS_RSA)};
        pg8::gemm_phase(lds, g, S, E);
    }
    SEAM(3);
    if (IN(4)) {
        for (int it = bid; it < 128; it += GSZ) {
            const int kv = it & 1, item = it >> 1;
            compress_item(lds, item, (const bf16_t*)(ws + WS_KB), kv ? args.in[8] : args.in[7], (const bf16_t*)(ws + (kv ? WS_WV1 : WS_WK1)), (const bf16_t*)(ws + (kv ? WS_WV2 : WS_WK2)),
                          (bf16_t*)(ws + WS_KC), (bf16_t*)(ws + WS_VCT), kv);
        }
        {
            const float* cw = args.in[13];
            bf16_t* CB = (bf16_t*)(ws + WS_CB); const bf16_t* CU = (const bf16_t*)(ws + WS_CU);
            const bool split = (GSZ >= 256);
            const int cw_first = split ? 128 : 0, cw_n = GSZ - cw_first;
            if (bid >= cw_first)
            for (int it = (bid - cw_first) * NTHREADS + tid; it < (M / 8) * 128; it += cw_n * NTHREADS) {
                const int cv = it & 127, tb = it >> 7, ch0 = cv * 8, ts = tb * 8;
                u32x4 uu[10], bb[8];
#pragma unroll
                for (int i = 0; i < 10; ++i) { const int t = ts - 2 + i; uu[i] = (t >= 0) ? *(const u32x4*)(CU + (size_t)t * D + ch0) : (u32x4){0u, 0u, 0u, 0u}; }
#pragma unroll
                for (int i = 0; i < 8; ++i) bb[i] = *(const u32x4*)(CB + (size_t)(ts + i) * D + ch0);
                float w0[8], w1[8], w2[8];
#pragma unroll
                for (int i = 0; i < 8; ++i) { w0[i] = cw[ch0 + i]; w1[i] = cw[1024 + ch0 + i]; w2[i] = cw[2048 + ch0 + i]; }
#pragma unroll
                for (int tt = 0; tt < 8; ++tt) {
                    const u32x4 a = uu[tt], b = uu[tt + 1], c = uu[tt + 2], bv = bb[tt];
                    float y[8];
                    y[0] = bflo(bv.x) * (w0[0] * bflo(a.x) + w1[0] * bflo(b.x) + w2[0] * bflo(c.x)); y[1] = bfhi(bv.x) * (w0[1] * bfhi(a.x) + w1[1] * bfhi(b.x) + w2[1] * bfhi(c.x));
                    y[2] = bflo(bv.y) * (w0[2] * bflo(a.y) + w1[2] * bflo(b.y) + w2[2] * bflo(c.y)); y[3] = bfhi(bv.y) * (w0[3] * bfhi(a.y) + w1[3] * bfhi(b.y) + w2[3] * bfhi(c.y));
                    y[4] = bflo(bv.z) * (w0[4] * bflo(a.z) + w1[4] * bflo(b.z) + w2[4] * bflo(c.z)); y[5] = bfhi(bv.z) * (w0[5] * bfhi(a.z) + w1[5] * bfhi(b.z) + w2[5] * bfhi(c.z));
                    y[6] = bflo(bv.w) * (w0[6] * bflo(a.w) + w1[6] * bflo(b.w) + w2[6] * bflo(c.w)); y[7] = bfhi(bv.w) * (w0[7] * bfhi(a.w) + w1[7] * bfhi(b.w) + w2[7] * bfhi(c.w));
                    u32x4 o; o.x = cvt_pk_bf16(y[0], y[1]); o.y = cvt_pk_bf16(y[2], y[3]); o.z = cvt_pk_bf16(y[4], y[5]); o.w = cvt_pk_bf16(y[6], y[7]);
                    *(u32x4*)(CB + (size_t)(ts + tt) * D + ch0) = o;
                }
            }
        }
        {
            __syncthreads();
            LAS float* scr = (LAS float*)(lds + wave * 16384);
            constexpr int I_SQ = 16 * 32, I_UP = 16 * 176, I_DN = 44 * 32;
            constexpr int NIT = 3 * I_SQ + I_UP + I_DN;
            const bool lsplit = (GSZ >= 256);
            const int lgw = lsplit ? (bid - 128) * NWAVES + wave : gw, lngw = lsplit ? (GSZ - 128) * NWAVES : NGW;
            if (!lsplit || bid >= 128)
            for (int it = lgw; it < NIT; it += lngw) {
                int r = it;
                if (r < I_SQ) { const int kb = r / 32, nb = r % 32; tr_item(args.in[14], D, D, nb * 32, 32, nullptr, (bf16_t*)(ws + WS_WNA), nb * 32, kb * 64, scr, lane); continue; } r -= I_SQ;
                if (r < I_SQ) { const int kb = r / 32, nb = r % 32; tr_item(args.in[15], D, D, nb * 32, 32, nullptr, (bf16_t*)(ws + WS_WCO), nb * 32, kb * 64, scr, lane); continue; } r -= I_SQ;
                if (r < I_SQ) { const int kb = r / 32, nb = r % 32; tr_item(args.in[16], D, D, nb * 32, 32, nullptr, (bf16_t*)(ws + WS_WO), nb * 32, kb * 64, scr, lane); continue; } r -= I_SQ;
                if (r < I_UP) { conv_ffn_up_item(args.in[18], args.in[19], args.in[17], (bf16_t*)(ws + WS_W2A), r, scr, lane); continue; } r -= I_UP;
                { const int kb = r / 32, nb = r % 32; tr_item(args.in[20], FF, D, nb * 32, 32, nullptr, (bf16_t*)(ws + WS_W2D), nb * 32, kb * 64, scr, lane); }
            }
            __syncthreads();
        }
    }
    SEAM(4);
    if (IN(5)) {
        for (int p2 = bid; p2 < 512; p2 += GSZ) {
            const int p = p2 & 255, g = p & 1, xq = p >> 1;
            const int cur = (p2 < 256) ? 255 - xq : xq;
            attn_unit(lds, g, cur, (const bf16_t*)(ws + WS_KC), (const bf16_t*)(ws + WS_VCT), (const bf16_t*)(ws + WS_KB), (const bf16_t*)(ws + WS_VT), (const bf16_t*)(ws + WS_QO), (bf16_t*)(ws + WS_QO), (const float*)(ws + WS_G));
        }
    }
    SEAM(5);
    if (IN(6)) {
        { pg8::Gemm g{(const bf16_t*)(ws + WS_QO), (const bf16_t*)(ws + WS_WNA), M, D, D}; pg8::StaticOrder S; S.init(M, D, GSZ, bid);
          pg8::EpiMerge<0> E{(bf16_t*)(ws + WS_GA), (const bf16_t*)(ws + WS_GA)}; pg8::gemm_phase(lds, g, S, E); }
        { pg8::Gemm g{(const bf16_t*)(ws + WS_CB), (const bf16_t*)(ws + WS_WCO), M, D, D}; pg8::StaticOrder S; S.init(M, D, GSZ, bid);
          pg8::EpiMerge<1> E{(bf16_t*)(ws + WS_GA), (const bf16_t*)(ws + WS_GB)}; pg8::gemm_phase(lds, g, S, E); }
    }
    SEAM(6);
    if (IN(7)) {
        pg8::Gemm g{(const bf16_t*)(ws + WS_GA), (const bf16_t*)(ws + WS_WO), M, D, D}; pg8::StaticOrder S; S.init(M, D, GSZ, bid);
        pg8::EpiRes E{out, out, (bf16_t*)(ws + WS_QO), (float*)(ws + WS_RSB), 1.0f};
        pg8::gemm_phase(lds, g, S, E);
    }
    SEAM(7);
    if (IN(8)) {
        pg8::Gemm g{(const bf16_t*)(ws + WS_QO), (const bf16_t*)(ws + WS_W2A), M, 2 * FF, D}; pg8::StaticOrder S; S.init(M, 2 * FF, GSZ, bid);
        pg8::EpiSwiglu E{(bf16_t*)(ws + WS_HB), (const float*)(ws + WS_RSB)};
        pg8::gemm_phase(lds, g, S, E);
    }
    SEAM(8);
    const bool fused_final = (GSZ == 256);
    if (IN(9)) {
        pg8::Gemm g{(const bf16_t*)(ws + WS_HB), (const bf16_t*)(ws + WS_W2D), M, D, FF}; pg8::StaticOrder S; S.init(M, D, GSZ, bid);
        if (fused_final) { pg8::EpiFinal E{out, (float*)(ws + WS_RSC), (unsigned*)(ws + WS_PCNT), args.in[21]}; pg8::gemm_phase(lds, g, S, E); }
        else { pg8::EpiRes E{out, out, nullptr, nullptr, 0.5f}; pg8::gemm_phase(lds, g, S, E); }
    }
    if (!fused_final) {
    SEAM(9);
    if (IN(10)) {
        const float* gn = args.in[21];
        for (int m = gw; m < M; m += NGW) {
            f32x4* xr = (f32x4*)(out + (size_t)m * D) + lane; const f32x4* gr = (const f32x4*)gn + lane;
            f32x4 v[4]; float ss = 0.f;
#pragma unroll
            for (int j = 0; j < 4; ++j) { v[j] = xr[64 * j]; ss += (v[j].x * v[j].x + v[j].y * v[j].y) + (v[j].z * v[j].z + v[j].w * v[j].w); }
            const float rs = rsqrtf(wave_sum(ss) * (1.f / 1024.f) + EPS);
#pragma unroll
            for (int j = 0; j < 4; ++j) { const f32x4 gg = gr[64 * j]; xr[64 * j] = v[j] * rs * gg; }
        }
    }
    }
#undef IN
#undef SEAM
}

extern "C" void kernel_launch(void* const* d_in, const int* in_sizes, int n_in, void* d_out, int out_size, void* d_ws, size_t ws_size, hipStream_t stream) {
    static int grid = 0;
    if (grid == 0) {
        if (n_in != 22 || out_size != M * D || ws_size < WS_END) { fprintf(stderr, "kernel_launch: unexpected problem (n_in %d out %d ws %zu)\n", n_in, out_size, ws_size); grid = -1; return; }
        int dev = 0, cus = 0, per_cu = 0;
        hipGetDevice(&dev); hipDeviceGetAttribute(&cus, hipDeviceAttributeMultiprocessorCount, dev);
        if (hipFuncSetAttribute((const void*)nsa_fwd, hipFuncAttributeMaxDynamicSharedMemorySize, LDS_BYTES) != hipSuccess) { fprintf(stderr, "kernel_launch: hipFuncSetAttribute failed\n"); grid = -1; return; }
        hipOccupancyMaxActiveBlocksPerMultiprocessor(&per_cu, (const void*)nsa_fwd, NTHREADS, LDS_BYTES);
        (void)hipGetLastError();
        if (per_cu < 1) per_cu = 1;
        grid = cus;
    }
    if (grid < 0) return;
    if (hipMemsetAsync((char*)d_ws + WS_CTL, 0, CTL_BYTES, stream) != hipSuccess) { fprintf(stderr, "kernel_launch: memset failed\n"); return; }
    Args a{};
    for (int i = 0; i < 22; ++i) a.in[i] = (const float*)d_in[i];
    a.out = (float*)d_out; a.ws = (unsigned char*)d_ws;
#if MK_PER_PHASE
    for (int ph = 0; ph < 11; ++ph) {
        a.ph_lo = ph; a.ph_hi = ph + 1;
        void* kargs[] = {&a};
        hipError_t e = hipLaunchCooperativeKernel((const void*)nsa_fwd, dim3(grid), dim3(NTHREADS), kargs, LDS_BYTES, stream);
        if (e != hipSuccess) { fprintf(stderr, "cooperative launch failed: %s\n", hipGetErrorString(e)); break; }
    }
#else
    a.ph_lo = 0; a.ph_hi = 11;
    void* kargs[] = {&a};
    hipError_t e = hipLaunchCooperativeKernel((const void*)nsa_fwd, dim3(grid), dim3(NTHREADS), kargs, LDS_BYTES, stream);
    if (e != hipSuccess) fprintf(stderr, "cooperative launch failed: %s (grid %d)\n", hipGetErrorString(e), grid);
#endif
}
```
